# Optimizing an MI355X kernel written in HIP

```python
import math
import jax, jax.numpy as jnp
from jax import lax
import numpy as np


D_MODEL = 1024
BATCH = 4
SEQ = 8192
DEPTH = 2

HEAD_DIM = 64
GROUP_HEADS = 4
GROUP_WIDTH = GROUP_HEADS * HEAD_DIM
N_MIXERS = 4
D_MIX = N_MIXERS * GROUP_WIDTH
D_FF = 4 * D_MODEL
NORM_EPS = 1e-6

NUM_BUCKETS = 32
MAX_DISTANCE = 2048
N_BIAS_HEADS = 2 * GROUP_HEADS

DILATED_PATTERNS = ((128, 1), (512, 4), (2048, 16))
DIL_BLOCK = 128

LRU_WIDTH = GROUP_WIDTH
LRU_BLOCKS = GROUP_HEADS
LRU_BLOCK_DIM = LRU_WIDTH // LRU_BLOCKS
LRU_C = 8.0
CONV_WIDTH = 4

SSM_HEADS = GROUP_HEADS
SSM_HEAD_DIM = HEAD_DIM
SSM_INNER = SSM_HEADS * SSM_HEAD_DIM
SSM_GROUPS = 2
SSM_STATE = 128
SSM_CHUNK = 128
SSM_CONV_DIM = SSM_INNER + 2 * SSM_GROUPS * SSM_STATE

DIFF_HEADS = GROUP_HEADS
DIFF_V_DIM = HEAD_DIM
DIFF_QK_DIM = HEAD_DIM // 2
DIFF_BLOCK = 128

A_COLS = 3 * GROUP_WIDTH
B_COLS = 2 * LRU_WIDTH
C_COLS = SSM_INNER + SSM_CONV_DIM + SSM_HEADS
D_COLS = 3 * GROUP_WIDTH
P_IN = A_COLS + B_COLS + C_COLS + D_COLS

kernel_name = 'hybrid_parallel_heads_dilated_lru_ssd_diff'


def rms_norm(x, g, eps=NORM_EPS):
    xf = x.astype(jnp.float32)
    y = xf * lax.rsqrt(jnp.mean(xf * xf, axis=-1, keepdims=True) + eps)
    return (y * g.astype(jnp.float32)).astype(x.dtype)


def t5_bucket(dist):
    n = jnp.maximum(dist, 0)
    max_exact = NUM_BUCKETS // 2
    nf = jnp.maximum(n, 1).astype(jnp.float32)
    large = max_exact + (jnp.log(nf / max_exact) / math.log(MAX_DISTANCE / max_exact)
                         * (NUM_BUCKETS - max_exact)).astype(jnp.int32)
    large = jnp.minimum(large, NUM_BUCKETS - 1)
    return jnp.where(n < max_exact, n, large)


def causal_depthwise_conv(x, w, b):
    k = w.shape[0]
    y = lax.conv_general_dilated(x, w[:, None, :].astype(x.dtype), window_strides=(1,),
                                 padding=((k - 1, 0),), dimension_numbers=('NWC', 'WIO', 'NWC'),
                                 feature_group_count=x.shape[-1])
    return y + b.astype(x.dtype)


def dilated_window_attention(q, k, v, bias_table):
    bsz, s, h, dh = q.shape
    scale = dh ** -0.5
    qi = jnp.arange(DIL_BLOCK)[:, None]
    kj = jnp.arange(2 * DIL_BLOCK)[None, :]
    rel = qi + DIL_BLOCK - kj
    outs, lses = [], []
    for window, dil in DILATED_PATTERNS:
        span = window // dil
        L = s // dil
        nb = -(-L // DIL_BLOCK)
        Lp = nb * DIL_BLOCK

        def strided(t):
            t = t.reshape(bsz, L, dil, h, dh).transpose(0, 3, 2, 1, 4)
            t = jnp.pad(t, ((0, 0), (0, 0), (0, 0), (0, Lp - L), (0, 0)))
            return t.reshape(bsz, h, dil, nb, DIL_BLOCK, dh)

        def with_prev(t):
            prev = jnp.pad(t, ((0, 0), (0, 0), (0, 0), (1, 0), (0, 0), (0, 0)))[:, :, :, :-1]
            return jnp.concatenate([prev, t], axis=-2)

        qb = strided(q)
        kc = with_prev(strided(k))
        vc = with_prev(strided(v)).astype(jnp.float32)
        blk = jnp.arange(nb)[:, None, None]
        valid = (rel >= 0) & (rel <= span) & (blk * DIL_BLOCK + kj - DIL_BLOCK >= 0)
        bias = bias_table[t5_bucket(rel * dil)].astype(jnp.float32)
        bias = jnp.moveaxis(bias, -1, 0)[:, None, None]
        sc = jnp.einsum('bhrnqd,bhrnkd->bhrnqk', qb, kc).astype(jnp.float32) * scale + bias
        sc = jnp.where(valid, sc, -jnp.inf)
        m = jnp.max(sc, axis=-1, keepdims=True)
        e = jnp.exp(sc - m)
        den = jnp.sum(e, axis=-1, keepdims=True)
        o = jnp.einsum('bhrnqk,bhrnkd->bhrnqd', e, vc) / den
        lse = (m + jnp.log(den))[..., 0]
        o = o.reshape(bsz, h, dil, Lp, dh)[:, :, :, :L].transpose(0, 1, 3, 2, 4).reshape(bsz, h, s, dh)
        lse = lse.reshape(bsz, h, dil, Lp)[..., :L].transpose(0, 1, 3, 2).reshape(bsz, h, s)
        outs.append(o)
        lses.append(lse)
    wts = jax.nn.softmax(jnp.stack(lses), axis=0)
    out = jnp.sum(wts[..., None] * jnp.stack(outs), axis=0)
    return out.transpose(0, 2, 1, 3).reshape(bsz, s, h * dh).astype(q.dtype)


def rg_lru(xg, xr, conv_w, conv_b, wa, ba, wx, bx, lam):
    bsz, s, _ = xr.shape
    f32 = jnp.float32
    xc = causal_depthwise_conv(xr, conv_w, conv_b).astype(f32)
    xh = xc.reshape(bsz, s, LRU_BLOCKS, LRU_BLOCK_DIM)
    r = jax.nn.sigmoid(jnp.einsum('bshi,hij->bshj', xh, wa.astype(f32)).reshape(bsz, s, LRU_WIDTH) + ba)
    i = jax.nn.sigmoid(jnp.einsum('bshi,hij->bshj', xh, wx.astype(f32)).reshape(bsz, s, LRU_WIDTH) + bx)
    log_a = -LRU_C * r * jax.nn.softplus(-lam.astype(f32))
    a = jnp.exp(log_a)
    b = jnp.sqrt(-jnp.expm1(2.0 * log_a)) * (i * xc)

    def combine(left, right):
        return (left[0] * right[0], right[0] * left[1] + right[1])

    _, hs = lax.associative_scan(combine, (a, b), axis=1)
    return (jax.nn.gelu(xg.astype(f32), approximate=True) * hs).astype(xr.dtype)


def segsum(a):
    t = a.shape[-1]
    cs = jnp.cumsum(a, axis=-1)
    diff = cs[..., :, None] - cs[..., None, :]
    mask = jnp.tril(jnp.ones((t, t), dtype=bool))
    return jnp.where(mask, diff, -jnp.inf)


def mamba2_ssd(z, xbc, dt, conv_w, conv_b, dt_bias, a_log, d_skip, norm_gain):
    bsz, s, _ = z.shape
    f32 = jnp.float32
    xbc = jax.nn.silu(causal_depthwise_conv(xbc, conv_w, conv_b).astype(f32))
    xs, bm, cm = jnp.split(xbc, [SSM_INNER, SSM_INNER + SSM_GROUPS * SSM_STATE], axis=-1)
    dt = jax.nn.softplus(dt.astype(f32) + dt_bias)
    a = -jnp.exp(a_log.astype(f32))
    nc = s // SSM_CHUNK
    rh = SSM_HEADS // SSM_GROUPS
    xh = xs.reshape(bsz, nc, SSM_CHUNK, SSM_GROUPS, rh, SSM_HEAD_DIM)
    dth = dt.reshape(bsz, nc, SSM_CHUNK, SSM_GROUPS, rh)
    xdt = xh * dth[..., None]
    bm = bm.reshape(bsz, nc, SSM_CHUNK, SSM_GROUPS, SSM_STATE)
    cm = cm.reshape(bsz, nc, SSM_CHUNK, SSM_GROUPS, SSM_STATE)
    adt = (dth * a.reshape(SSM_GROUPS, rh)).transpose(0, 3, 4, 1, 2)
    a_cum = jnp.cumsum(adt, axis=-1)
    lmat = jnp.exp(segsum(adt))
    cb = jnp.einsum('bclgn,bcsgn->bcgls', cm, bm)
    y_diag = jnp.einsum('bcgls,bgrcls,bcsgrp->bclgrp', cb, lmat, xdt)
    decay_states = jnp.exp(a_cum[..., -1:] - a_cum)
    states = jnp.einsum('bcsgn,bgrcs,bcsgrp->bcgrpn', bm, decay_states, xdt)
    chunk_decay = jnp.exp(a_cum[..., -1])

    def step(carry, inp):
        st, dec = inp
        return carry * dec[..., None, None] + st, carry

    init = jnp.zeros((bsz, SSM_GROUPS, rh, SSM_HEAD_DIM, SSM_STATE), f32)
    _, prev = lax.scan(step, init, (jnp.moveaxis(states, 1, 0), jnp.moveaxis(chunk_decay, -1, 0)))
    prev = jnp.moveaxis(prev, 0, 1)
    y_off = jnp.einsum('bclgn,bcgrpn,bgrcl->bclgrp', cm, prev, jnp.exp(a_cum))
    y = y_diag + y_off + xh * d_skip.astype(f32).reshape(SSM_GROUPS, rh)[..., None]
    y = y.reshape(bsz, s, SSM_INNER) * jax.nn.silu(z.astype(f32))
    y = rms_norm(y.reshape(bsz, s, SSM_GROUPS, SSM_INNER // SSM_GROUPS),
                 norm_gain.reshape(SSM_GROUPS, SSM_INNER // SSM_GROUPS))
    return y.reshape(bsz, s, SSM_INNER).astype(z.dtype)


def diff_attention(q, k, v, lam, lam_init, bias_table, sub_gain):
    bsz, s, h = q.shape[:3]
    scale = DIFF_QK_DIM ** -0.5
    nb = s // DIFF_BLOCK
    qb = q.reshape(bsz, nb, DIFF_BLOCK, h, 2, DIFF_QK_DIM).transpose(1, 0, 3, 4, 2, 5)
    kt = k.transpose(0, 2, 3, 1, 4)
    vt = v.transpose(0, 2, 1, 3).astype(jnp.float32)
    kpos = jnp.arange(s)

    def one_block(args):
        qblk, bi = args
        qpos = bi * DIFF_BLOCK + jnp.arange(DIFF_BLOCK)
        dist = qpos[:, None] - kpos[None, :]
        bias = jnp.moveaxis(bias_table[t5_bucket(dist)].astype(jnp.float32), -1, 0)
        sc = jnp.einsum('bhcqd,bhckd->bhcqk', qblk, kt).astype(jnp.float32) * scale + bias[:, None]
        sc = jnp.where(dist >= 0, sc, -jnp.inf)
        p = jax.nn.softmax(sc, axis=-1)
        attn = p[:, :, 0] - lam * p[:, :, 1]
        return jnp.einsum('bhqk,bhkd->bhqd', attn, vt)

    o = lax.map(one_block, (qb, jnp.arange(nb)))
    o = o.transpose(1, 0, 3, 2, 4).reshape(bsz, s, h, DIFF_V_DIM)
    o = rms_norm(o, sub_gain) * (1.0 - lam_init)
    return o.reshape(bsz, s, h * DIFF_V_DIM).astype(q.dtype)


def setup_inputs(seed: int = 0) -> dict:
    key = jax.random.key(seed)
    ks = jax.random.split(key, 32)
    f32 = jnp.float32

    def nrm(k, shape, scale):
        return jax.random.normal(k, shape, f32) * scale

    def gain(k, shape):
        return 1.0 + 0.05 * jax.random.normal(k, shape, f32)

    u = jax.random.uniform(ks[12], (DEPTH, LRU_WIDTH), f32, 0.9, 0.999)
    a_base = u ** (1.0 / LRU_C)
    lru_lambda = jnp.log(a_base) - jnp.log1p(-a_base)
    dt0 = jnp.exp(jax.random.uniform(ks[15], (DEPTH, SSM_HEADS), f32, math.log(1e-3), math.log(1e-1)))
    ssm_dt_bias = dt0 + jnp.log(-jnp.expm1(-dt0))
    return {
        'x': nrm(ks[0], (BATCH, SEQ, D_MODEL), 1.0),
        'rel_bias': nrm(ks[1], (NUM_BUCKETS, N_BIAS_HEADS), 0.5),
        'norm_mix_pre': gain(ks[2], (DEPTH, D_MODEL)),
        'norm_mix_post': gain(ks[3], (DEPTH, D_MODEL)),
        'norm_ffn_pre': gain(ks[4], (DEPTH, D_MODEL)),
        'norm_ffn_post': gain(ks[5], (DEPTH, D_MODEL)),
        'w_in': nrm(ks[6], (DEPTH, D_MODEL, P_IN), D_MODEL ** -0.5),
        'w_out': nrm(ks[7], (DEPTH, D_MIX, D_MODEL), D_MIX ** -0.5),
        'lru_conv_w': nrm(ks[8], (DEPTH, CONV_WIDTH, LRU_WIDTH), CONV_WIDTH ** -0.5),
        'lru_conv_b': nrm(ks[9], (DEPTH, LRU_WIDTH), 0.02),
        'lru_wa': nrm(ks[10], (DEPTH, LRU_BLOCKS, LRU_BLOCK_DIM, LRU_BLOCK_DIM), LRU_BLOCK_DIM ** -0.5),
        'lru_ba': nrm(ks[11], (DEPTH, LRU_WIDTH), 0.02),
        'lru_wx': nrm(ks[13], (DEPTH, LRU_BLOCKS, LRU_BLOCK_DIM, LRU_BLOCK_DIM), LRU_BLOCK_DIM ** -0.5),
        'lru_bx': nrm(ks[14], (DEPTH, LRU_WIDTH), 0.02),
        'lru_lambda': lru_lambda,
        'ssm_conv_w': nrm(ks[16], (DEPTH, CONV_WIDTH, SSM_CONV_DIM), CONV_WIDTH ** -0.5),
        'ssm_conv_b': nrm(ks[17], (DEPTH, SSM_CONV_DIM), 0.02),
        'ssm_dt_bias': ssm_dt_bias,
        'ssm_a_log': jnp.log(jax.random.uniform(ks[18], (DEPTH, SSM_HEADS), f32, 1.0, 16.0)),
        'ssm_d': 1.0 + 0.1 * jax.random.normal(ks[19], (DEPTH, SSM_HEADS), f32),
        'ssm_norm': gain(ks[20], (DEPTH, SSM_INNER)),
        'diff_lq1': nrm(ks[21], (DEPTH, DIFF_QK_DIM), 0.1),
        'diff_lk1': nrm(ks[22], (DEPTH, DIFF_QK_DIM), 0.1),
        'diff_lq2': nrm(ks[23], (DEPTH, DIFF_QK_DIM), 0.1),
        'diff_lk2': nrm(ks[24], (DEPTH, DIFF_QK_DIM), 0.1),
        'diff_norm': gain(ks[25], (DEPTH, DIFF_V_DIM)),
        'w_ff_up': nrm(ks[26], (DEPTH, D_MODEL, D_FF), D_MODEL ** -0.5),
        'w_ff_down': nrm(ks[27], (DEPTH, D_FF, D_MODEL), D_FF ** -0.5),
    }


def reference(x, rel_bias, norm_mix_pre, norm_mix_post, norm_ffn_pre, norm_ffn_post, w_in, w_out,
              lru_conv_w, lru_conv_b, lru_wa, lru_ba, lru_wx, lru_bx, lru_lambda,
              ssm_conv_w, ssm_conv_b, ssm_dt_bias, ssm_a_log, ssm_d, ssm_norm,
              diff_lq1, diff_lk1, diff_lq2, diff_lk2, diff_norm, w_ff_up, w_ff_down):
    bsz, s, _ = x.shape
    h = x
    for layer in range(DEPTH):
        u = rms_norm(h, norm_mix_pre[layer])
        proj = jnp.einsum('bsd,dp->bsp', u, w_in[layer])
        pa, pb, pc, pd = jnp.split(proj, [A_COLS, A_COLS + B_COLS, A_COLS + B_COLS + C_COLS], axis=-1)

        qa, ka, va = (t.reshape(bsz, s, GROUP_HEADS, HEAD_DIM) for t in jnp.split(pa, 3, axis=-1))
        ya = dilated_window_attention(qa, ka, va, rel_bias[:, :GROUP_HEADS])

        gb, xb = jnp.split(pb, 2, axis=-1)
        yb = rg_lru(gb, xb, lru_conv_w[layer], lru_conv_b[layer], lru_wa[layer], lru_ba[layer],
                    lru_wx[layer], lru_bx[layer], lru_lambda[layer])

        zc, xbc, dtc = jnp.split(pc, [SSM_INNER, SSM_INNER + SSM_CONV_DIM], axis=-1)
        yc = mamba2_ssd(zc, xbc, dtc, ssm_conv_w[layer], ssm_conv_b[layer], ssm_dt_bias[layer],
                        ssm_a_log[layer], ssm_d[layer], ssm_norm[layer])

        qd, kd, vd = jnp.split(pd, 3, axis=-1)
        lam_init = 0.8 - 0.6 * math.exp(-0.3 * layer)
        lam = (jnp.exp(jnp.sum(diff_lq1[layer].astype(jnp.float32) * diff_lk1[layer].astype(jnp.float32)))
               - jnp.exp(jnp.sum(diff_lq2[layer].astype(jnp.float32) * diff_lk2[layer].astype(jnp.float32)))
               + lam_init)
        yd = diff_attention(qd.reshape(bsz, s, DIFF_HEADS, 2, DIFF_QK_DIM),
                            kd.reshape(bsz, s, DIFF_HEADS, 2, DIFF_QK_DIM),
                            vd.reshape(bsz, s, DIFF_HEADS, DIFF_V_DIM),
                            lam, lam_init, rel_bias[:, GROUP_HEADS:], diff_norm[layer])

        mix = jnp.concatenate([ya, yb, yc, yd], axis=-1)
        h = h + rms_norm(jnp.einsum('bsm,md->bsd', mix, w_out[layer]), norm_mix_post[layer])

        u = rms_norm(h, norm_ffn_pre[layer])
        f = jnp.square(jax.nn.relu(jnp.einsum('bsd,df->bsf', u, w_ff_up[layer])))
        h = h + rms_norm(jnp.einsum('bsf,fd->bsd', f, w_ff_down[layer]), norm_ffn_post[layer])
    return h
```

```cpp
#include <hip/hip_runtime.h>
#include <cstdio>
#include <cstdint>
#include <cmath>
#include <hip/hip_cooperative_groups.h>
__device__ __forceinline__ int mk_tid() { int t = (int)threadIdx.x; asm volatile("" : "+v"(t)); return t; }
namespace pg8 {
#define PG8_LAS __attribute__((address_space(3)))
typedef unsigned short bf16_t;
typedef short bf16x8 __attribute__((ext_vector_type(8)));
typedef float f32x4 __attribute__((ext_vector_type(4)));
typedef unsigned u32x4 __attribute__((ext_vector_type(4)));
constexpr int BM = 256, BK = 64, HALF = 128, HTB = HALF * BK * 2  , STAGE_BYTES = 8 * HTB, NXCD = 8, WGM = 8;

__host__ __device__ __forceinline__ int lds_byte(int r, int c) { const int st = (r >> 4) * 2 + (c >> 5), rr = r & 15, cc = c & 31, ob = rr * 64 + cc * 2; return st * 1024 + (ob ^ (((ob >> 9) & 1) << 5)); }
__host__ __device__ __forceinline__ void stage_rc(int b, int& R, int& C) { const int st = b / 1024, sb = b % 1024, swz = sb ^ (((sb >> 9) & 1) << 5); R = (st >> 1) * 16 + swz / 64; C = (st & 1) * 32 + (swz % 64) / 2; }
__host__ __device__ __forceinline__ int perm32(int rho) { const int n = rho >> 4, i = rho & 15; return 8 * (i >> 2) + 4 * n + (i & 3); }

struct Unit { int pm, pn; };
struct Gemm { const bf16_t* A; const bf16_t* Bt; int M, N, K, pad; };

struct StaticOrder {
    int nM, nN, nwg, G, c;
    __host__ __device__ void init(int M, int N, int G_, int c_) { nM = M / BM; nN = N / BM; nwg = nM * nN; G = G_; c = c_; }
    __host__ __device__ bool next(int i, Unit& u) const {
        const long L = (long)i * G + c; if (L >= nwg) return false;
        int wgid = (int)L; { const int q = nwg / NXCD, r = nwg % NXCD, xcd = wgid % NXCD, off = wgid / NXCD; wgid = (xcd < r ? xcd * (q + 1) : r * (q + 1) + (xcd - r) * q) + off; }
        const int nig = WGM * nN, gid = wgid / nig, fm = gid * WGM, gsz = (nM - fm) < WGM ? (nM - fm) : WGM;
        u.pm = fm + ((wgid % nig) % gsz); u.pn = (wgid % nig) / gsz; return true;
    }
    __device__ __forceinline__ void a_ready(const Unit&) const {}
    __device__ __forceinline__ void done(const Unit&) const {}
};

__device__ __forceinline__ unsigned cvt_pk_bf16(float lo, float hi) { unsigned r; asm volatile("v_cvt_pk_bf16_f32 %0, %1, %2" : "=v"(r) : "v"(lo), "v"(hi)); return r; }
typedef float f32x2 __attribute__((ext_vector_type(2)));
__device__ __forceinline__ f32x2 gelu_pk(f32x2 v) {
    const f32x2 av = __builtin_elementwise_abs(v), d = av * 0.2316418882f + 1.0f;
    f32x2 t; t.x = __builtin_amdgcn_rcpf(d.x); t.y = __builtin_amdgcn_rcpf(d.y);
    f32x2 q = t * 0.5307027145f + (-0.7265760135f); q = q * t + 0.7107068705f; q = q * t + (-0.142248368f); q = q * t + 0.127414796f; q = q * t;
    const f32x2 s = (v * v) * (-0.72134752044f);
    f32x2 e; e.x = __builtin_amdgcn_exp2f(s.x); e.y = __builtin_amdgcn_exp2f(s.y);
    const f32x2 m = v * (q * e), r = v - m;
    f32x2 o; o.x = v.x < 0.f ? m.x : r.x; o.y = v.y < 0.f ? m.y : r.y; return o;
}

template <int ACT  > struct EpiBf16 {
    static constexpr bool PERM = true, AFTER_DRAIN = false; static_assert(ACT == 0 || ACT == 1, "EpiBf16: ACT is 0 (none) or 1 (gelu_pk)");
    bf16_t* O; int ldc; const float* bias; int split_cols; size_t split_stride; float scale0;
    __device__ __forceinline__ void operator()(const f32x4 (&acc)[2][2][4][2], const Unit& u, int wr, int wc, int fr, int fq) const {
        const int row0 = u.pm * BM + wr * 64 + fr; int colt = u.pn * BM; bf16_t* base = O;
        float sc = 1.f; if (split_cols) { const int t = colt / split_cols; base += (size_t)t * split_stride; colt -= t * split_cols; if (t == 0) sc = scale0; }
        const int col0 = colt + wc * 32 + 8 * fq, bcol0 = u.pn * BM + wc * 32 + 8 * fq;
        f32x4 bv[2][2];
#pragma unroll
        for (int bj = 0; bj < 2; ++bj)
#pragma unroll
            for (int n = 0; n < 2; ++n) bv[bj][n] = bias ? *(const f32x4*)(bias + bcol0 + bj * HALF + 4 * n) : (f32x4){0.f, 0.f, 0.f, 0.f};
#pragma unroll
        for (int ai = 0; ai < 2; ++ai)
#pragma unroll
            for (int m = 0; m < 4; ++m) { bf16_t* rowp = base + (size_t)(row0 + ai * HALF + m * 16) * ldc + col0;
#pragma unroll
                for (int bj = 0; bj < 2; ++bj) { f32x4 v0 = acc[ai][bj][m][0] + bv[bj][0], v1 = acc[ai][bj][m][1] + bv[bj][1];
                    if (ACT == 1) { f32x2 a = gelu_pk((f32x2){v0[0], v0[1]}), b = gelu_pk((f32x2){v0[2], v0[3]}), c = gelu_pk((f32x2){v1[0], v1[1]}), d = gelu_pk((f32x2){v1[2], v1[3]});
                        v0 = (f32x4){a.x, a.y, b.x, b.y}; v1 = (f32x4){c.x, c.y, d.x, d.y}; }
                    v0 = v0 * sc; v1 = v1 * sc; u32x4 w; w.x = cvt_pk_bf16(v0[0], v0[1]); w.y = cvt_pk_bf16(v0[2], v0[3]); w.z = cvt_pk_bf16(v1[0], v1[1]); w.w = cvt_pk_bf16(v1[2], v1[3]);
                    *(u32x4*)(rowp + bj * HALF) = w; } }
    }
};

struct PanelStats {
    unsigned* xbuf;
    unsigned* cnt;
    unsigned* tmo;
    int ntn; float eps;
    unsigned code;
    __device__ __forceinline__ bool run(const f32x4 (&v)[2][2][4][2], const Unit& u, int wr, int wc, int fr, int fq, PG8_LAS unsigned char* lds, int wid, int lane) const {
        typedef float f32x2v __attribute__((ext_vector_type(2)));
        PG8_LAS f32x2v* P = (PG8_LAS f32x2v*)lds;
        PG8_LAS f32x2v* S = (PG8_LAS f32x2v*)(lds + 8192);
        PG8_LAS unsigned* flag = (PG8_LAS unsigned*)(lds + 8192 + 2048);
#pragma unroll
        for (int ai = 0; ai < 2; ++ai)
#pragma unroll
            for (int m = 0; m < 4; ++m) {
                float s = 0.f;
#pragma unroll
                for (int bj = 0; bj < 2; ++bj)
#pragma unroll
                    for (int n = 0; n < 2; ++n) { const f32x4 x = v[ai][bj][m][n]; s += (x[0] + x[1]) + (x[2] + x[3]); }
                s += __shfl_xor(s, 16); s += __shfl_xor(s, 32);
                const float mw = s * (1.0f / 64.0f); float q = 0.f;
#pragma unroll
                for (int bj = 0; bj < 2; ++bj)
#pragma unroll
                    for (int n = 0; n < 2; ++n) { const f32x4 d = v[ai][bj][m][n] - mw; q += (d[0] * d[0] + d[1] * d[1]) + (d[2] * d[2] + d[3] * d[3]); }
                q += __shfl_xor(q, 16); q += __shfl_xor(q, 32);
                if (fq == 0) P[(ai * HALF + wr * 64 + m * 16 + fr) * 4 + wc] = (f32x2v){mw, q};
            }
        asm volatile("s_waitcnt lgkmcnt(0)" ::: "memory"); __builtin_amdgcn_s_barrier(); asm volatile("" ::: "memory");
#if defined(BROKEN_EXCHANGE_NO_WAIT)
#warning BROKEN CONTROL BUILD: the row-statistics exchange does not wait; results are wrong by design
        if (blockIdx.x >= 64) { const long long t0_ = clock64(); while (clock64() - t0_ < 60000) __builtin_amdgcn_s_sleep(8); }
#endif
        const int row = wid * 32 + (lane & 31);
        if (lane < 32) {
            const f32x2v a = P[row * 4 + 0], b = P[row * 4 + 1], c = P[row * 4 + 2], d = P[row * 4 + 3];
            const float mt = (a.x + b.x + c.x + d.x) * 0.25f;
            const float da = a.x - mt, db = b.x - mt, dc = c.x - mt, dd = d.x - mt;
            const float m2 = (a.y + b.y) + (c.y + d.y) + 64.0f * ((da * da + db * db) + (dc * dc + dd * dd));
            unsigned long long* slot = (unsigned long long*)xbuf + ((size_t)(u.pm * BM + row) * 4 + u.pn);
            __hip_atomic_store(slot, ((unsigned long long)__float_as_uint(m2) << 32) | __float_as_uint(mt), __ATOMIC_RELAXED, __HIP_MEMORY_SCOPE_AGENT);
        }
        asm volatile("s_waitcnt vmcnt(0)" ::: "memory");
        if (lane == 0) __hip_atomic_fetch_add(cnt + 64 * u.pm, 1u, __ATOMIC_RELAXED, __HIP_MEMORY_SCOPE_AGENT);
        if (wid == 0) {
            bool dead = false; const unsigned long long t0 = __builtin_amdgcn_s_memrealtime(); const unsigned want = 8u * (unsigned)ntn;
            for (;;) {
#if defined(BROKEN_EXCHANGE_NO_WAIT)
                break;
#endif
                if ((unsigned)__builtin_amdgcn_readfirstlane(__hip_atomic_load(cnt + 64 * u.pm, __ATOMIC_RELAXED, __HIP_MEMORY_SCOPE_AGENT)) >= want) break;
                if (__builtin_amdgcn_s_memrealtime() - t0 > 2000000ull) {
                    if (lane == 0) { unsigned expect = 0u; __hip_atomic_compare_exchange_strong(tmo + 1, &expect, code | (unsigned)(u.pm & 0xff), __ATOMIC_RELAXED, __ATOMIC_RELAXED, __HIP_MEMORY_SCOPE_AGENT);
                                     __hip_atomic_store(tmo, 1u, __ATOMIC_RELAXED, __HIP_MEMORY_SCOPE_AGENT); }
                    dead = true; break; }
                __builtin_amdgcn_s_sleep(2);
            }
            __builtin_amdgcn_fence(__ATOMIC_ACQUIRE, "agent");
            if (lane == 0) flag[0] = dead ? 1u : 0u;
        }
        asm volatile("s_waitcnt vmcnt(0) lgkmcnt(0)" ::: "memory"); __builtin_amdgcn_s_barrier(); asm volatile("" ::: "memory");
        const bool bad = flag[0] != 0u;
        if (lane < 32) {
            const unsigned long long* slot = (const unsigned long long*)xbuf + (size_t)(u.pm * BM + row) * 4; float mt[4], m2[4]; float ms = 0.f;
#pragma unroll
            for (int t = 0; t < 4; ++t) { if (t < ntn) { const unsigned long long w = __hip_atomic_load(slot + t, __ATOMIC_RELAXED, __HIP_MEMORY_SCOPE_AGENT); mt[t] = __uint_as_float((unsigned)w); m2[t] = __uint_as_float((unsigned)(w >> 32)); } else { mt[t] = 0.f; m2[t] = 0.f; } ms += mt[t]; }
            const float mean = ms / (float)ntn; float q = 0.f;
#pragma unroll
            for (int t = 0; t < 4; ++t) if (t < ntn) { const float dm = mt[t] - mean; q += m2[t] + 256.0f * dm * dm; }
            S[row] = (f32x2v){mean, 1.0f / sqrtf(q / (256.0f * (float)ntn) + eps)};
        }
        asm volatile("s_waitcnt lgkmcnt(0)" ::: "memory"); __builtin_amdgcn_s_barrier(); asm volatile("" ::: "memory");
        return bad;
    }
};
struct EpiLnRes {
    static constexpr bool PERM = false, AFTER_DRAIN = true;
    const float* base; float* out; int ldc; const float* bias; PanelStats st; unsigned poison;
    __device__ __forceinline__ void fused(f32x4 (&acc)[2][2][4][2], const Unit& u, int wr, int wc, int fr, int fq, PG8_LAS unsigned char* lds, int wid, int lane) const {
        typedef float f32x2v __attribute__((ext_vector_type(2)));
        const PG8_LAS f32x2v* S = (const PG8_LAS f32x2v*)(lds + 8192);
        const int col0 = u.pn * BM + wc * 32 + 4 * fq;
#pragma unroll
        for (int bj = 0; bj < 2; ++bj)
#pragma unroll
            for (int n = 0; n < 2; ++n) { const f32x4 bv = bias ? *(const f32x4*)(bias + col0 + bj * HALF + n * 16) : (f32x4){0.f, 0.f, 0.f, 0.f};
#pragma unroll
                for (int ai = 0; ai < 2; ++ai)
#pragma unroll
                    for (int m = 0; m < 4; ++m) acc[ai][bj][m][n] += bv; }
        f32x4 pre[4][2][2];
#pragma unroll
        for (int m = 0; m < 4; ++m) { const size_t off = (size_t)(u.pm * BM + wr * 64 + m * 16 + fr) * ldc + col0;
#pragma unroll
            for (int bj = 0; bj < 2; ++bj)
#pragma unroll
                for (int n = 0; n < 2; ++n) pre[m][bj][n] = *(const f32x4*)(base + off + bj * HALF + n * 16); }
        const bool bad = st.run(acc, u, wr, wc, fr, fq, lds, wid, lane) || poison != 0u;
        const float qnan = __builtin_nanf("");
#pragma unroll
        for (int ai = 0; ai < 2; ++ai)
#pragma unroll
            for (int m = 0; m < 4; ++m) { const int r = ai * HALF + wr * 64 + m * 16 + fr; const f32x2v sr = S[r]; const size_t off = (size_t)(u.pm * BM + r) * ldc + col0;
#pragma unroll
                for (int bj = 0; bj < 2; ++bj)
#pragma unroll
                    for (int n = 0; n < 2; ++n) { const f32x4 bs = ai == 0 ? pre[m][bj][n] : *(const f32x4*)(base + off + bj * HALF + n * 16); f32x4 o = bs + (acc[ai][bj][m][n] - sr.x) * sr.y;
                        if (bad) o = (f32x4){qnan, qnan, qnan, qnan}; *(f32x4*)(out + off + bj * HALF + n * 16) = o; }
                if (m & 1) asm volatile("" ::: "memory"); }
    }
};
struct EpiLnResLn {
    static constexpr bool PERM = false, AFTER_DRAIN = true;
    const float* base; float* out; bf16_t* xn; int ldc; const float* bias; PanelStats st1, st2; unsigned poison;
    __device__ __forceinline__ void fused(f32x4 (&acc)[2][2][4][2], const Unit& u, int wr, int wc, int fr, int fq, PG8_LAS unsigned char* lds, int wid, int lane) const {
        typedef float f32x2v __attribute__((ext_vector_type(2))); typedef unsigned u32x2v __attribute__((ext_vector_type(2)));
        const PG8_LAS f32x2v* S = (const PG8_LAS f32x2v*)(lds + 8192);
        const int col0 = u.pn * BM + wc * 32 + 4 * fq;
#pragma unroll
        for (int bj = 0; bj < 2; ++bj)
#pragma unroll
            for (int n = 0; n < 2; ++n) { const f32x4 bv = bias ? *(const f32x4*)(bias + col0 + bj * HALF + n * 16) : (f32x4){0.f, 0.f, 0.f, 0.f};
#pragma unroll
                for (int ai = 0; ai < 2; ++ai)
#pragma unroll
                    for (int m = 0; m < 4; ++m) acc[ai][bj][m][n] += bv; }
        bool bad = st1.run(acc, u, wr, wc, fr, fq, lds, wid, lane) || poison != 0u;
        const float qnan = __builtin_nanf("");
#pragma unroll
        for (int ai = 0; ai < 2; ++ai)
#pragma unroll
            for (int m = 0; m < 4; ++m) { const int r = ai * HALF + wr * 64 + m * 16 + fr; const f32x2v sr = S[r]; const size_t off = (size_t)(u.pm * BM + r) * ldc + col0;
#pragma unroll
                for (int bj = 0; bj < 2; ++bj)
#pragma unroll
                    for (int n = 0; n < 2; ++n) { const f32x4 bs = *(const f32x4*)(base + off + bj * HALF + n * 16); acc[ai][bj][m][n] = bs + (acc[ai][bj][m][n] - sr.x) * sr.y; }
                asm volatile("" : "+v"(acc[ai][0][m][0]), "+v"(acc[ai][0][m][1]), "+v"(acc[ai][1][m][0]), "+v"(acc[ai][1][m][1]));
                if (m & 1) asm volatile("" ::: "memory"); }
        const bool bad1 = bad;
        bad = st2.run(acc, u, wr, wc, fr, fq, lds, wid, lane) || bad;
#pragma unroll
        for (int ai = 0; ai < 2; ++ai)
#pragma unroll
            for (int m = 0; m < 4; ++m) { const int r = ai * HALF + wr * 64 + m * 16 + fr; const f32x2v sr = S[r]; const size_t off = (size_t)(u.pm * BM + r) * ldc + col0;
#pragma unroll
                for (int bj = 0; bj < 2; ++bj)
#pragma unroll
                    for (int n = 0; n < 2; ++n) { const f32x4 x1 = acc[ai][bj][m][n]; *(f32x4*)(out + off + bj * HALF + n * 16) = bad1 ? (f32x4){qnan, qnan, qnan, qnan} : x1;
                        const f32x4 o = (x1 - sr.x) * sr.y; u32x2v w; w.x = cvt_pk_bf16(o[0], o[1]); w.y = cvt_pk_bf16(o[2], o[3]);
                        if (bad) { w.x = 0x7fc07fc0u; w.y = 0x7fc07fc0u; } *(u32x2v*)(xn + off + bj * HALF + n * 16) = w; }
                asm volatile("" ::: "memory"); }
    }
};

template <class Epi, class Sched, bool ALIGN_EPI = false, bool SP2 = false>
__device__ __forceinline__ void gemm_phase(PG8_LAS unsigned char* lds, const Gemm g, const Sched& S, const Epi& E) {
    const int tid = mk_tid(), wid = __builtin_amdgcn_readfirstlane(tid >> 6), lane = tid & 63, wr = wid >> 2, wc = wid & 3, fr = lane & 15, fq = lane >> 4;
    const int K = g.K, nt = K / BK;
    unsigned voffA[2], voffB[2];
#pragma unroll
    for (int i = 0; i < 2; ++i) { int R, C; stage_rc(tid * 16 + i * 8192, R, C); const int Rb = Epi::PERM ? ((R & ~31) + perm32(R & 31)) : R;
        voffA[i] = (unsigned)(R * K + C) * 2u; voffB[i] = (unsigned)(Rb * K + C) * 2u; }
    const size_t kstep = (size_t)(BK * 2);
    const size_t hstep = (size_t)HALF * K * 2;
    const size_t tstep = 2 * hstep;
    const unsigned ldsw = (unsigned)wid * 1024u;
    const int aoff = lds_byte(wr * 64 + fr, fq * 8), boff = lds_byte(wc * 32 + fr, fq * 8);
#define PG8_SA(b, h) (((b) * 2 + (h)) * HTB)
#define PG8_SB(b, h) ((4 + (b) * 2 + (h)) * HTB)
#define PG8_STAGE(bufoff, gbase, voff) do { _Pragma("unroll") for (int _i = 0; _i < 2; ++_i) \
        __builtin_amdgcn_global_load_lds((const unsigned*)((const char*)(gbase) + (voff)[_i]), (PG8_LAS unsigned*)(lds + (bufoff) + ldsw + _i * 8192), 16, 0, 0); } while (0)
#define PG8_LDA(dst, b, h) do { _Pragma("unroll") for (int m = 0; m < 4; ++m) _Pragma("unroll") for (int k = 0; k < 2; ++k) dst[m][k] = *(const PG8_LAS bf16x8*)(lds + PG8_SA(b, h) + aoff + m * 2048 + k * 1024); } while (0)
#define PG8_LDB(dst, b, h) do { _Pragma("unroll") for (int n = 0; n < 2; ++n) _Pragma("unroll") for (int k = 0; k < 2; ++k) dst[n][k] = *(const PG8_LAS bf16x8*)(lds + PG8_SB(b, h) + boff + n * 2048 + k * 1024); } while (0)
#define PG8_MMA(ai, bj, At, Bt) do { __builtin_amdgcn_s_setprio(1); _Pragma("unroll") for (int m = 0; m < 4; ++m) _Pragma("unroll") for (int n = 0; n < 2; ++n) _Pragma("unroll") for (int k = 0; k < 2; ++k) \
        acc[ai][bj][m][n] = __builtin_amdgcn_mfma_f32_16x16x32_bf16(Bt[n][k], At[m][k], acc[ai][bj][m][n], 0, 0, 0); __builtin_amdgcn_s_setprio(0); } while (0)
#define PG8_WAIT_V(n) asm volatile("s_waitcnt vmcnt(" #n ")" ::: "memory")
#define PG8_WAIT_L(n) asm volatile("s_waitcnt lgkmcnt(" #n ")" ::: "memory")
#define PG8_BAR __builtin_amdgcn_s_barrier()
#define PG8_SCHED __builtin_amdgcn_sched_barrier(0)
    Unit cur, nxt; int ui = 0;
    if (!S.next(0, cur)) return;
    f32x4 acc[2][2][4][2];
#pragma unroll
    for (int a = 0; a < 2; ++a)
#pragma unroll
        for (int b = 0; b < 2; ++b)
#pragma unroll
            for (int m = 0; m < 4; ++m)
#pragma unroll
                for (int n = 0; n < 2; ++n) acc[a][b][m][n] = (f32x4){0.f, 0.f, 0.f, 0.f};
    bf16x8 At[4][2], B0[2][2], B1[2][2];
    const char* cA = (const char*)g.A + (size_t)cur.pm * tstep; const char* cB = (const char*)g.Bt + (size_t)cur.pn * tstep;
    S.a_ready(cur);
    if constexpr (SP2) {
        PG8_STAGE(PG8_SB(0, 0), cB, voffB); PG8_STAGE(PG8_SB(0, 1), cB + hstep, voffB); PG8_STAGE(PG8_SA(0, 0), cA, voffA); PG8_STAGE(PG8_SA(0, 1), cA + hstep, voffA);
        if (wr == 1) PG8_BAR;
        PG8_WAIT_V(2); PG8_BAR;
        PG8_STAGE(PG8_SB(1, 0), cB + kstep, voffB); PG8_STAGE(PG8_SA(1, 0), cA + kstep, voffA); PG8_STAGE(PG8_SB(1, 1), cB + hstep + kstep, voffB);
        PG8_WAIT_V(6); PG8_BAR;
    } else {
        PG8_STAGE(PG8_SB(0, 0), cB, voffB); PG8_STAGE(PG8_SA(0, 0), cA, voffA); PG8_STAGE(PG8_SB(0, 1), cB + hstep, voffB); PG8_STAGE(PG8_SA(0, 1), cA + hstep, voffA);
        if (wr == 1) PG8_BAR;
        PG8_WAIT_V(4); PG8_BAR;
        PG8_STAGE(PG8_SB(1, 0), cB + kstep, voffB); PG8_STAGE(PG8_SA(1, 0), cA + kstep, voffA); PG8_STAGE(PG8_SB(1, 1), cB + hstep + kstep, voffB);
        PG8_WAIT_V(6); PG8_BAR;
    }
    for (;;) {
        const bool has_next = S.next(ui + 1, nxt);
        const char* nA = has_next ? (const char*)g.A + (size_t)nxt.pm * tstep : cA; const char* nB = has_next ? (const char*)g.Bt + (size_t)nxt.pn * tstep : cB;
        for (int t = 0; t < nt; t += 2) {
            const bool last = (t == nt - 2);
            const char* a1 = cA + (size_t)(t + 1) * kstep;
            const char* a2 = last ? nA : cA + (size_t)(t + 2) * kstep; const char* b2 = last ? nB : cB + (size_t)(t + 2) * kstep;
            const char* a3 = a2 + kstep; const char* b3 = b2 + kstep;
            if (last && has_next) S.a_ready(nxt);
            if constexpr (SP2) {
            PG8_LDB(B0, 0, 0); PG8_LDB(B1, 0, 1); PG8_SCHED; PG8_LDA(At, 0, 0); PG8_STAGE(PG8_SA(1, 1), a1 + hstep, voffA);
            PG8_WAIT_V(8); PG8_WAIT_L(0); PG8_BAR; PG8_MMA(0, 0, At, B0); PG8_MMA(0, 1, At, B1); PG8_BAR; PG8_SCHED;
            PG8_LDA(At, 0, 1); PG8_STAGE(PG8_SB(0, 0), b2, voffB); PG8_STAGE(PG8_SB(0, 1), b2 + hstep, voffB); PG8_STAGE(PG8_SA(0, 0), a2, voffA);
            PG8_WAIT_V(8); PG8_WAIT_L(0); PG8_BAR; PG8_MMA(1, 0, At, B0); PG8_MMA(1, 1, At, B1); PG8_BAR; PG8_SCHED;
            PG8_LDB(B0, 1, 0); PG8_LDB(B1, 1, 1); PG8_SCHED; PG8_LDA(At, 1, 0); PG8_STAGE(PG8_SA(0, 1), a2 + hstep, voffA);
            PG8_WAIT_V(8); PG8_WAIT_L(0); PG8_BAR; PG8_MMA(0, 0, At, B0); PG8_MMA(0, 1, At, B1); PG8_BAR; PG8_SCHED;
            PG8_LDA(At, 1, 1); PG8_STAGE(PG8_SB(1, 0), b3, voffB); PG8_STAGE(PG8_SB(1, 1), b3 + hstep, voffB); PG8_STAGE(PG8_SA(1, 0), a3, voffA);
            PG8_WAIT_V(8); PG8_WAIT_L(0); PG8_BAR; PG8_MMA(1, 0, At, B0); PG8_MMA(1, 1, At, B1); PG8_BAR; PG8_SCHED;
            } else {
            PG8_LDB(B0, 0, 0); PG8_SCHED; PG8_LDA(At, 0, 0); PG8_STAGE(PG8_SA(1, 1), a1 + hstep, voffA);
            PG8_WAIT_L(8); PG8_BAR; PG8_WAIT_L(0); PG8_MMA(0, 0, At, B0); PG8_BAR; PG8_SCHED;
            PG8_LDB(B1, 0, 1); PG8_STAGE(PG8_SB(0, 0), b2, voffB);
            PG8_BAR; PG8_WAIT_L(0); PG8_MMA(0, 1, At, B1); PG8_BAR;
            PG8_LDA(At, 0, 1); PG8_STAGE(PG8_SA(0, 0), a2, voffA);
            PG8_BAR; PG8_WAIT_L(0); PG8_MMA(1, 0, At, B0); PG8_BAR; PG8_SCHED;
            PG8_STAGE(PG8_SB(0, 1), b2 + hstep, voffB);
            PG8_WAIT_V(6); PG8_BAR; PG8_MMA(1, 1, At, B1); PG8_BAR;
            PG8_LDB(B0, 1, 0); PG8_SCHED; PG8_LDA(At, 1, 0); PG8_STAGE(PG8_SA(0, 1), a2 + hstep, voffA);
            PG8_WAIT_L(8); PG8_BAR; PG8_WAIT_L(0); PG8_MMA(0, 0, At, B0); PG8_BAR; PG8_SCHED;
            PG8_LDB(B1, 1, 1); PG8_STAGE(PG8_SB(1, 0), b3, voffB);
            PG8_BAR; PG8_WAIT_L(0); PG8_MMA(0, 1, At, B1); PG8_BAR;
            PG8_LDA(At, 1, 1); PG8_STAGE(PG8_SA(1, 0), a3, voffA);
            PG8_BAR; PG8_WAIT_L(0); PG8_MMA(1, 0, At, B0); PG8_BAR; PG8_SCHED;
            PG8_STAGE(PG8_SB(1, 1), b3 + hstep, voffB);
            PG8_WAIT_V(6); PG8_BAR; PG8_MMA(1, 1, At, B1); PG8_BAR;
            }
        }
        if constexpr (ALIGN_EPI) { if (wr == 0) PG8_BAR; }
        if constexpr (!Epi::AFTER_DRAIN) { E(acc, cur, wr, wc, fr, fq); S.done(cur); }
        if (!has_next) break;
#pragma unroll
        for (int a = 0; a < 2; ++a)
#pragma unroll
            for (int b = 0; b < 2; ++b)
#pragma unroll
                for (int m = 0; m < 4; ++m)
#pragma unroll
                    for (int n = 0; n < 2; ++n) acc[a][b][m][n] = (f32x4){0.f, 0.f, 0.f, 0.f};
        cur = nxt; cA = nA; cB = nB; ++ui;
        if constexpr (ALIGN_EPI) { if (wr == 1) PG8_BAR; }
    }
    PG8_WAIT_V(0);
    if constexpr (!ALIGN_EPI) { if (wr == 0) PG8_BAR; }
    PG8_BAR;
    if constexpr (Epi::AFTER_DRAIN) { E.fused(acc, cur, wr, wc, fr, fq, lds, wid, lane); S.done(cur); }
#undef PG8_SA
#undef PG8_SB
#undef PG8_STAGE
#undef PG8_LDA
#undef PG8_LDB
#undef PG8_MMA
#undef PG8_WAIT_V
#undef PG8_WAIT_L
#undef PG8_BAR
#undef PG8_SCHED
}
}

namespace pg8 {
template <int ACT> struct EpiBf16R {
    static constexpr bool PERM = true, AFTER_DRAIN = false;
    bf16_t* O; int ldc, pad;
    __device__ __forceinline__ void operator()(const f32x4 (&acc)[2][2][4][2], const Unit& u, int wr, int wc, int fr, int fq) const {
        const int row0 = u.pm * BM + wr * 64 + fr; const int col0 = u.pn * BM + wc * 32 + 8 * fq;
#pragma unroll
        for (int ai = 0; ai < 2; ++ai)
#pragma unroll
            for (int m = 0; m < 4; ++m) { bf16_t* rowp = O + (size_t)(row0 + ai * HALF + m * 16) * ldc + col0;
#pragma unroll
                for (int bj = 0; bj < 2; ++bj) { f32x4 v0 = acc[ai][bj][m][0], v1 = acc[ai][bj][m][1];
                    if (ACT == 2) {
#pragma unroll
                        for (int e = 0; e < 4; ++e) { float a = v0[e] > 0.f ? v0[e] : 0.f; v0[e] = a * a; float b = v1[e] > 0.f ? v1[e] : 0.f; v1[e] = b * b; } }
                    u32x4 w; w.x = cvt_pk_bf16(v0[0], v0[1]); w.y = cvt_pk_bf16(v0[2], v0[3]); w.z = cvt_pk_bf16(v1[0], v1[1]); w.w = cvt_pk_bf16(v1[2], v1[3]);
                    *(u32x4*)(rowp + bj * HALF) = w; } }
    }
};
struct EpiF32 {
    static constexpr bool PERM = false, AFTER_DRAIN = false;
    float* O; int ldc, pad;
    __device__ __forceinline__ void operator()(const f32x4 (&acc)[2][2][4][2], const Unit& u, int wr, int wc, int fr, int fq) const {
        const int col0 = u.pn * BM + wc * 32 + 4 * fq;
#pragma unroll
        for (int ai = 0; ai < 2; ++ai)
#pragma unroll
            for (int m = 0; m < 4; ++m) { const size_t off = (size_t)(u.pm * BM + ai * HALF + wr * 64 + m * 16 + fr) * ldc + col0;
#pragma unroll
                for (int bj = 0; bj < 2; ++bj)
#pragma unroll
                    for (int n = 0; n < 2; ++n) *(f32x4*)(O + off + bj * HALF + n * 16) = acc[ai][bj][m][n]; }
    }
};
}

namespace mk {
typedef unsigned short bf16;
typedef short bf16x8 __attribute__((ext_vector_type(8)));
typedef short s16x4 __attribute__((ext_vector_type(4)));
typedef float f32x4 __attribute__((ext_vector_type(4)));
typedef float f32x16 __attribute__((ext_vector_type(16)));
typedef unsigned u32x4 __attribute__((ext_vector_type(4)));
typedef unsigned u32x2 __attribute__((ext_vector_type(2)));
#define MK_LAS __attribute__((address_space(3)))

constexpr int BATCH = 4, SEQ = 8192, DM = 1024, DFF = 4096, MROWS = BATCH * SEQ, NPROJ = 3072, PIN = 3076, DEPTH = 2, NT = 512;
constexpr float EPS = 1e-6f, LOG2E = 1.4426950408889634f, NEGS = -30000.f, MINIT = -10000.f;
constexpr int PA_Q = 0, PA_K = 256, PA_V = 512, PB_G = 768, PB_X = 1024, PC_Z = 1280, PC_XBC = 1536, PD_Q = 2304, PD_K = 2560, PD_V = 2816;
constexpr int MX_A = 0, MX_B = 256, MX_C = 512, MX_D = 768;

constexpr size_t MiB = 1u << 20;
constexpr size_t WS_CTL = 0, WS_TBL = 1 * MiB, WS_W = 2 * MiB, W_LAYER = 24 * MiB, WS_DT = 52 * MiB, WS_LSUM = 53 * MiB, WS_CDEC = 54 * MiB,
                 WS_XN = 64 * MiB, WS_PROJ = 128 * MiB, WS_MIX = 320 * MiB, WS_HID = 128 * MiB, WS_Y1 = 128 * MiB, WS_Y2 = 384 * MiB, WS_ST = 384 * MiB, WS_END = 512 * MiB;
constexpr size_t WO_IN = 0, WO_OUT = 6 * MiB, WO_UP = 8 * MiB, WO_DOWN = 16 * MiB;
constexpr size_t TB_D = 0  , TB_A = 32768  , TB_LAM = 40960  , TB_LRUW = 65536  ;
constexpr int LDS_BYTES = 147456;

enum { I_X = 0, I_RELB, I_NMPRE, I_NMPOST, I_NFPRE, I_NFPOST, I_WIN, I_WOUT, I_LCW, I_LCB, I_LWA, I_LBA, I_LWX, I_LBX, I_LLAM,
       I_SCW, I_SCB, I_SDTB, I_SALOG, I_SD, I_SNORM, I_LQ1, I_LK1, I_LQ2, I_LK2, I_DNORM, I_WUP, I_WDOWN, N_IN };
struct Params { const float* in[N_IN]; float* out; unsigned char* ws; };

__device__ __forceinline__ unsigned f2bf(float f) { unsigned u = __float_as_uint(f); return (u + 0x7fffu + ((u >> 16) & 1u)) >> 16; }
__device__ __forceinline__ float bf2f(unsigned short b) { return __uint_as_float(((unsigned)b) << 16); }
__device__ __forceinline__ unsigned pk2(float lo, float hi) { return f2bf(lo) | (f2bf(hi) << 16); }
__device__ __forceinline__ int crow(int r, int hi) { return (r & 3) + 8 * (r >> 2) + 4 * hi; }
__device__ __forceinline__ float wave_sum(float v) {
#pragma unroll
    for (int o = 1; o < 64; o <<= 1) v += __shfl_xor(v, o);
    return v;
}
__device__ __forceinline__ int t5_bucket(int n) {
    if (n < 16) return n;
    return 16 + (n >= 22) + (n >= 30) + (n >= 40) + (n >= 54) + (n >= 73) + (n >= 99) + (n >= 134) + (n >= 182) + (n >= 246) + (n >= 332) + (n >= 450) + (n >= 609) + (n >= 825) + (n >= 1117) + (n >= 1513);
}
__device__ __forceinline__ f32x16 mfma32(bf16x8 a, bf16x8 b, f32x16 c) { return __builtin_amdgcn_mfma_f32_32x32x16_bf16(a, b, c, 0, 0, 0); }
__device__ __forceinline__ bf16x8 pack8(const f32x16& p, int base) {
    u32x4 w; w.x = pk2(p[base + 0], p[base + 1]); w.y = pk2(p[base + 2], p[base + 3]); w.z = pk2(p[base + 4], p[base + 5]); w.w = pk2(p[base + 6], p[base + 7]);
    return __builtin_bit_cast(bf16x8, w);
}
typedef short v4i16_t __attribute__((ext_vector_type(4)));
__device__ __forceinline__ s16x4 vtr(const unsigned char* p) {
    return __builtin_bit_cast(s16x4, __builtin_amdgcn_ds_read_tr16_b64_v4i16((MK_LAS v4i16_t*)(p)));
}
__device__ __forceinline__ bf16x8 vfrag(const unsigned char* p) {
    const s16x4 lo = vtr(p), hi = vtr(p + 512);
    return (bf16x8){lo[0], lo[1], lo[2], lo[3], hi[0], hi[1], hi[2], hi[3]};
}
#define MK_LDSFENCE() asm volatile("s_waitcnt lgkmcnt(0)" ::: "memory")

__device__ __forceinline__ void tr_item(const float* W, int K, int Nsrc, bf16* WT, int k0, int n0, bool remap, float* scr, int tid) {
    const int c = tid & 63, r0 = tid >> 6;
#pragma unroll
    for (int i = 0; i < 8; ++i) { const int k = r0 + 8 * i; const int n = n0 + c; const int sn = (remap && n >= 2304) ? n + 4 : n; scr[k * 65 + c] = W[(size_t)(k0 + k) * Nsrc + sn]; }
    __syncthreads();
#pragma unroll
    for (int i = 0; i < 8; ++i) { const int n = r0 + 8 * i; WT[(size_t)(n0 + n) * K + k0 + c] = (bf16)f2bf(scr[c * 65 + n]); }
    __syncthreads();
}
__device__ __forceinline__ void ph_prep(const Params& P, unsigned char* lds) {
    float* scr = (float*)lds; const int tid = mk_tid();
    constexpr int T_IN = 16 * 48, T_OUT = 16 * 16, T_UP = 16 * 64, T_DOWN = 64 * 16, T_L = T_IN + T_OUT + T_UP + T_DOWN;
    for (int it = blockIdx.x; it < DEPTH * T_L; it += gridDim.x) {
        const int layer = it / T_L; int r = it % T_L; bf16* wl = (bf16*)(P.ws + WS_W + (size_t)layer * W_LAYER);
        if (r < T_IN) { tr_item(P.in[I_WIN] + (size_t)layer * DM * PIN, DM, PIN, wl + WO_IN / 2, (r / 48) * 64, (r % 48) * 64, true, scr, tid); continue; } r -= T_IN;
        if (r < T_OUT) { tr_item(P.in[I_WOUT] + (size_t)layer * DM * DM, DM, DM, wl + WO_OUT / 2, (r / 16) * 64, (r % 16) * 64, false, scr, tid); continue; } r -= T_OUT;
        if (r < T_UP) { tr_item(P.in[I_WUP] + (size_t)layer * DM * DFF, DM, DFF, wl + WO_UP / 2, (r / 64) * 64, (r % 64) * 64, false, scr, tid); continue; } r -= T_UP;
        tr_item(P.in[I_WDOWN] + (size_t)layer * DFF * DM, DFF, DM, wl + WO_DOWN / 2, (r / 16) * 64, (r % 16) * 64, false, scr, tid);
    }
    const int gid = blockIdx.x * NT + tid, gn = gridDim.x * NT;
    const float* rb = P.in[I_RELB];
    float* tD = (float*)(P.ws + WS_TBL + TB_D); float* tA = (float*)(P.ws + WS_TBL + TB_A); float* tL = (float*)(P.ws + WS_TBL + TB_LAM);
    for (int i = gid; i < 4 * 2048; i += gn) { const int h = i >> 11, d = i & 2047; tD[i] = (rb[t5_bucket(d) * 8 + 4 + h] - rb[31 * 8 + 4 + h]) * LOG2E; }
    for (int i = gid; i < 3 * 4 * 132; i += gn) { const int p = i / (4 * 132), h = (i / 132) & 3, j = i % 132; const int dil = p == 0 ? 1 : (p == 1 ? 4 : 16);
        tA[i] = (j <= 128) ? rb[t5_bucket(j * dil) * 8 + h] * LOG2E : NEGS; }
    if (gid < DEPTH) { const int layer = gid; float s1 = 0.f, s2 = 0.f;
        for (int i = 0; i < 32; ++i) { s1 += P.in[I_LQ1][layer * 32 + i] * P.in[I_LK1][layer * 32 + i]; s2 += P.in[I_LQ2][layer * 32 + i] * P.in[I_LK2][layer * 32 + i]; }
        const float lam_init = 0.8f - 0.6f * expf(-0.3f * (float)layer); tL[layer] = expf(s1) - expf(s2) + lam_init; }
    bf16* lw = (bf16*)(P.ws + WS_TBL + TB_LRUW);
    for (int i = gid; i < DEPTH * 2 * 4 * 64 * 64; i += gn) { const int ii = i & 63, j = (i >> 6) & 63, hb = (i >> 12) & 3, g = (i >> 14) & 1, layer = i >> 15;
        const float* src = (g ? P.in[I_LWX] : P.in[I_LWA]) + (size_t)layer * 4 * 64 * 64; lw[i] = (bf16)f2bf(src[(hb * 64 + ii) * 64 + j]); }
}

__device__ __forceinline__ void ph_row(const float* Y, const float* gpost, const float* base, float* hout, const float* gnext, bf16* XN, const float* Wdt, float* DT) {
    const int tid_ = mk_tid(); const int lane = tid_ & 63, gw = blockIdx.x * (NT / 64) + (tid_ >> 6), ngw = gridDim.x * (NT / 64);
    for (int m = gw; m < MROWS; m += ngw) {
        f32x4 hv[4];
        const f32x4* bp = (const f32x4*)(base + (size_t)m * DM) + lane;
#pragma unroll
        for (int j = 0; j < 4; ++j) hv[j] = bp[64 * j];
        if (Y) {
            const f32x4* yp = (const f32x4*)(Y + (size_t)m * DM) + lane; f32x4 y[4]; float ss = 0.f;
#pragma unroll
            for (int j = 0; j < 4; ++j) { y[j] = yp[64 * j]; ss += (y[j].x * y[j].x + y[j].y * y[j].y) + (y[j].z * y[j].z + y[j].w * y[j].w); }
            ss = wave_sum(ss); const float r = 1.0f / sqrtf(ss * (1.0f / DM) + EPS);
            const f32x4* gp = (const f32x4*)gpost + lane; f32x4* hp = (f32x4*)(hout + (size_t)m * DM) + lane;
#pragma unroll
            for (int j = 0; j < 4; ++j) { hv[j] = hv[j] + y[j] * r * gp[64 * j]; hp[64 * j] = hv[j]; }
        }
        if (gnext) {
            float ss = 0.f;
#pragma unroll
            for (int j = 0; j < 4; ++j) ss += (hv[j].x * hv[j].x + hv[j].y * hv[j].y) + (hv[j].z * hv[j].z + hv[j].w * hv[j].w);
            ss = wave_sum(ss); const float r = 1.0f / sqrtf(ss * (1.0f / DM) + EPS);
            const f32x4* gp = (const f32x4*)gnext + lane; u32x2* xp = (u32x2*)(XN + (size_t)m * DM) + lane;
            f32x4 d = {0.f, 0.f, 0.f, 0.f};
#pragma unroll
            for (int j = 0; j < 4; ++j) { const f32x4 u = hv[j] * r * gp[64 * j]; u32x2 w; w.x = pk2(u.x, u.y); w.y = pk2(u.z, u.w); xp[64 * j] = w;
                if (Wdt) { const float* wp = Wdt + (size_t)(4 * (lane + 64 * j)) * PIN;
                    d = d + u.x * *(const f32x4*)(wp) + u.y * *(const f32x4*)(wp + PIN) + u.z * *(const f32x4*)(wp + 2 * PIN) + u.w * *(const f32x4*)(wp + 3 * PIN); } }
            if (Wdt) { d.x = wave_sum(d.x); d.y = wave_sum(d.y); d.z = wave_sum(d.z); d.w = wave_sum(d.w); if (lane == 0) *(f32x4*)(DT + (size_t)m * 4) = d; }
        }
    }
}

template <class Epi> __device__ __forceinline__ void ph_gemm(const pg8::Gemm g, const Epi e, unsigned char* lds) {
    pg8::StaticOrder S; S.init(g.M, g.N, (int)gridDim.x, (int)blockIdx.x);
    pg8::gemm_phase<Epi, pg8::StaticOrder, true, true>((PG8_LAS unsigned char*)lds, g, S, e);
}

__device__ __forceinline__ void ph_dilated(const Params& P, unsigned char* lds) {
    const int tid = mk_tid(), lane = tid & 63, wid = tid >> 6, r32 = lane & 31, hi = lane >> 5;
    float* tbl = (float*)lds;
    unsigned char* vst = lds + 13824 + wid * 4352;
    float* scr = (float*)(vst + 4096);
    const bf16* PROJ = (const bf16*)(P.ws + WS_PROJ); bf16* MIX = (bf16*)(P.ws + WS_MIX);
    const float* tA = (const float*)(P.ws + WS_TBL + TB_A);
    for (int item = blockIdx.x; item < 512; item += gridDim.x) {
        const int half = item & 1, chunk = (item >> 1) & 15, h = (item >> 5) & 3, b = item >> 7;
        __syncthreads();
        for (int i = tid; i < 3 * 1152; i += NT) { const int p = i / 1152, j = (i % 1152) - 496; tbl[i] = (j >= 0 && j <= 128) ? tA[(p * 4 + h) * 132 + j] : NEGS; }
        __syncthreads();
        const int rres = half * 8 + wid, T0 = chunk * 512, Tmax = T0 + rres + 496;
        const bf16* base = PROJ + (size_t)b * SEQ * NPROJ;
        bf16x8 qf[4];
        { const bf16* qp = base + (size_t)(T0 + rres + 16 * r32) * NPROJ + PA_Q + h * 64 + hi * 8; const float c2 = 0.125f * LOG2E;
#pragma unroll
          for (int s = 0; s < 4; ++s) { const bf16x8 q = *(const bf16x8*)(qp + 16 * s); u32x4 w;
              w.x = pk2(bf2f((bf16)q[0]) * c2, bf2f((bf16)q[1]) * c2); w.y = pk2(bf2f((bf16)q[2]) * c2, bf2f((bf16)q[3]) * c2);
              w.z = pk2(bf2f((bf16)q[4]) * c2, bf2f((bf16)q[5]) * c2); w.w = pk2(bf2f((bf16)q[6]) * c2, bf2f((bf16)q[7]) * c2); qf[s] = __builtin_bit_cast(bf16x8, w); } }
        float m = MINIT, l = 0.f; f32x16 o0 = {}, o1 = {};
        for (int p = 0; p < 3; ++p) {
            const int dl = p == 0 ? 1 : (p == 1 ? 4 : 16), rho = 16 / dl, ntile = (rho * 31 + 128) / 32 + 1, kmaxp = Tmax / dl, kq = rho * (31 - r32);
            for (int tau = 0; tau < ntile; ++tau) {
                const int k0 = 32 * tau;
                bf16x8 kf[4];
                { int pos = Tmax - dl * (k0 + r32); pos = pos < 0 ? 0 : pos; const bf16* kp = base + (size_t)pos * NPROJ + PA_K + h * 64 + hi * 8;
#pragma unroll
                  for (int s = 0; s < 4; ++s) kf[s] = *(const bf16x8*)(kp + 16 * s); }
#pragma unroll
                for (int i = 0; i < 4; ++i) { const int ci = lane + 64 * i, krow = ci >> 3, ch = ci & 7; int pos = Tmax - dl * (k0 + krow); pos = pos < 0 ? 0 : pos;
                    const bf16x8 v = *(const bf16x8*)(base + (size_t)pos * NPROJ + PA_V + h * 64 + ch * 8);
                    *(bf16x8*)(vst + ((ch >> 2) * 2 + (krow >> 4)) * 1024 + (krow & 15) * 64 + (ch & 3) * 16) = v; }
                f32x16 acc;
                { const float* tb = tbl + p * 1152 + (k0 + 4 * hi - kq + 496);
#pragma unroll
                  for (int r = 0; r < 16; ++r) acc[r] = tb[(r & 3) + 8 * (r >> 2)]; }
#pragma unroll
                for (int s = 0; s < 4; ++s) acc = mfma32(kf[s], qf[s], acc);
#pragma unroll
                for (int r = 0; r < 16; ++r) if (k0 + crow(r, hi) > kmaxp) acc[r] = NEGS;
                float mx = acc[0];
#pragma unroll
                for (int r = 1; r < 16; ++r) mx = fmaxf(mx, acc[r]);
                mx = fmaxf(mx, __shfl_xor(mx, 32));
                const float mn = fmaxf(m, mx), f = exp2f(m - mn); m = mn;
                float ps = 0.f;
#pragma unroll
                for (int r = 0; r < 16; ++r) { acc[r] = exp2f(acc[r] - mn); ps += acc[r]; }
                l = l * f + ps;
                if (__any(f != 1.0f)) {
                    if (hi == 0) scr[r32] = f;
                    MK_LDSFENCE();
#pragma unroll
                    for (int r = 0; r < 16; ++r) { const float fr = scr[crow(r, hi)]; o0[r] *= fr; o1[r] *= fr; }
                }
                MK_LDSFENCE();
                const unsigned char* vb = vst + ((lane >> 4) & 1) * 32 + (lane & 3) * 8 + (4 * hi + ((lane & 15) >> 2)) * 64;
#pragma unroll
                for (int ks = 0; ks < 2; ++ks) { const bf16x8 pa = pack8(acc, 8 * ks);
                    o0 = mfma32(pa, vfrag(vb + ks * 1024), o0); o1 = mfma32(pa, vfrag(vb + 2048 + ks * 1024), o1); }
                MK_LDSFENCE();
            }
        }
        l += __shfl_xor(l, 32);
        if (hi == 0) scr[r32] = 1.0f / l;
        MK_LDSFENCE();
#pragma unroll
        for (int r = 0; r < 16; ++r) { const int q = crow(r, hi); const float inv = scr[q];
            bf16* op = MIX + ((size_t)b * SEQ + T0 + rres + 16 * q) * DM + MX_A + h * 64 + r32;
            op[0] = (bf16)f2bf(o0[r] * inv); op[32] = (bf16)f2bf(o1[r] * inv); }
        MK_LDSFENCE();
    }
}

__device__ __forceinline__ void diff_unit(const Params& P, int layer, int b, int h, int qb, unsigned char* lds) {
    const int tid = mk_tid(), lane = tid & 63, wid = tid >> 6, r32 = lane & 31, hi = lane >> 5;
    unsigned char* Kb = lds;
    unsigned char* Vb = lds + 16384;
    const float* tbl = (const float*)(lds + 32768);
    float* scr = (float*)(lds + 40960) + wid * 64;
    const bf16* PROJ = (const bf16*)(P.ws + WS_PROJ); bf16* MIX = (bf16*)(P.ws + WS_MIX);
    const bf16* base = PROJ + (size_t)b * SEQ * NPROJ;
    const int q0 = qb * 256, qw0 = q0 + 32 * wid, qabs = qw0 + r32, NTL = 4 * qb + 4;
    bf16x8 qf[2][2];
    { const bf16* qp = base + (size_t)qabs * NPROJ + PD_Q + h * 64 + hi * 8; const float c2 = 0.17677669529663687f * LOG2E;
#pragma unroll
      for (int c = 0; c < 2; ++c)
#pragma unroll
          for (int s = 0; s < 2; ++s) { const bf16x8 q = *(const bf16x8*)(qp + c * 32 + 16 * s); u32x4 w;
              w.x = pk2(bf2f((bf16)q[0]) * c2, bf2f((bf16)q[1]) * c2); w.y = pk2(bf2f((bf16)q[2]) * c2, bf2f((bf16)q[3]) * c2);
              w.z = pk2(bf2f((bf16)q[4]) * c2, bf2f((bf16)q[5]) * c2); w.w = pk2(bf2f((bf16)q[6]) * c2, bf2f((bf16)q[7]) * c2); qf[c][s] = __builtin_bit_cast(bf16x8, w); } }
    const int lrow = tid >> 3, lch = tid & 7;
    const bf16* kg = base + (size_t)lrow * NPROJ + PD_K + h * 64 + lch * 8;
    const bf16* vg = base + (size_t)lrow * NPROJ + PD_V + h * 64 + lch * 8;
    const int kdst = lrow * 128 + ((lch ^ (lrow & 7)) * 16), vdst = ((lch >> 2) * 4 + (lrow >> 4)) * 1024 + (lrow & 15) * 64 + (lch & 3) * 16;
    { const bf16x8 k = *(const bf16x8*)kg, v = *(const bf16x8*)vg; *(bf16x8*)(Kb + kdst) = k; *(bf16x8*)(Vb + vdst) = v; }
    float m[2] = {MINIT, MINIT}, l[2] = {0.f, 0.f}; f32x16 o[2][2]; o[0][0] = f32x16{}; o[0][1] = f32x16{}; o[1][0] = f32x16{}; o[1][1] = f32x16{};
    __syncthreads();
    for (int j = 0; j < NTL; ++j) {
        bf16x8 kn = {}, vn = {};
        if (j + 1 < NTL) { kn = *(const bf16x8*)(kg + (size_t)(j + 1) * 64 * NPROJ); vn = *(const bf16x8*)(vg + (size_t)(j + 1) * 64 * NPROJ); }
        const int k0 = 64 * j;
        if (k0 <= qw0 + 31) {
            const unsigned char* Kt = Kb + (j & 1) * 8192; const unsigned char* Vt = Vb + (j & 1) * 8192;
            f32x16 sc[2][2];
            const bool near = (qw0 - k0 - 63) < 1513;
#pragma unroll
            for (int kh = 0; kh < 2; ++kh) {
                f32x16 init = {};
                if (near) { const int dq = qabs - k0 - 32 * kh - 4 * hi;
#pragma unroll
                    for (int r = 0; r < 16; ++r) { int d = dq - ((r & 3) + 8 * (r >> 2)); d = d < 0 ? 0 : d; init[r] = tbl[d]; } }
                const int key = 32 * kh + r32; const unsigned char* kr = Kt + key * 128;
#pragma unroll
                for (int c = 0; c < 2; ++c) { f32x16 a = init;
#pragma unroll
                    for (int s = 0; s < 2; ++s) { const int chunk = c * 4 + 2 * s + hi; a = mfma32(*(const bf16x8*)(kr + ((chunk ^ (key & 7)) * 16)), qf[c][s], a); }
                    sc[c][kh] = a; }
            }
            if (k0 + 63 > qw0) {
#pragma unroll
                for (int kh = 0; kh < 2; ++kh)
#pragma unroll
                    for (int r = 0; r < 16; ++r) if (k0 + 32 * kh + crow(r, hi) > qabs) { sc[0][kh][r] = NEGS; sc[1][kh][r] = NEGS; }
            }
            float fsc[2];
#pragma unroll
            for (int c = 0; c < 2; ++c) {
                float mx = sc[c][0][0];
#pragma unroll
                for (int r = 1; r < 16; ++r) mx = fmaxf(mx, sc[c][0][r]);
#pragma unroll
                for (int r = 0; r < 16; ++r) mx = fmaxf(mx, sc[c][1][r]);
                mx = fmaxf(mx, __shfl_xor(mx, 32));
                const float mn = fmaxf(m[c], mx), f = exp2f(m[c] - mn); m[c] = mn; fsc[c] = f;
                float ps = 0.f;
#pragma unroll
                for (int r = 0; r < 16; ++r) { sc[c][0][r] = exp2f(sc[c][0][r] - mn); ps += sc[c][0][r]; }
#pragma unroll
                for (int r = 0; r < 16; ++r) { sc[c][1][r] = exp2f(sc[c][1][r] - mn); ps += sc[c][1][r]; }
                l[c] = l[c] * f + ps;
            }
            if (__any(fsc[0] != 1.0f || fsc[1] != 1.0f)) {
                if (hi == 0) { scr[r32] = fsc[0]; scr[32 + r32] = fsc[1]; }
                MK_LDSFENCE();
#pragma unroll
                for (int r = 0; r < 16; ++r) { const int q = crow(r, hi); const float f0 = scr[q], f1 = scr[32 + q];
                    o[0][0][r] *= f0; o[0][1][r] *= f0; o[1][0][r] *= f1; o[1][1][r] *= f1; }
                MK_LDSFENCE();
            }
            const unsigned char* vb = Vt + ((lane >> 4) & 1) * 32 + (lane & 3) * 8 + (4 * hi + ((lane & 15) >> 2)) * 64;
#pragma unroll
            for (int ks = 0; ks < 4; ++ks) {
                const bf16x8 v0 = vfrag(vb + ks * 1024), v1 = vfrag(vb + 4096 + ks * 1024);
                const bf16x8 p0 = pack8(sc[0][ks >> 1], 8 * (ks & 1)), p1 = pack8(sc[1][ks >> 1], 8 * (ks & 1));
                o[0][0] = mfma32(p0, v0, o[0][0]); o[0][1] = mfma32(p0, v1, o[0][1]);
                o[1][0] = mfma32(p1, v0, o[1][0]); o[1][1] = mfma32(p1, v1, o[1][1]);
            }
        }
        if (j + 1 < NTL) { *(bf16x8*)(Kb + ((j + 1) & 1) * 8192 + kdst) = kn; *(bf16x8*)(Vb + ((j + 1) & 1) * 8192 + vdst) = vn; }
        __syncthreads();
    }
    const float lam = ((const float*)(P.ws + WS_TBL + TB_LAM))[layer];
    const float lam_init = 0.8f - 0.6f * expf(-0.3f * (float)layer);
    l[0] += __shfl_xor(l[0], 32); l[1] += __shfl_xor(l[1], 32);
    if (hi == 0) { scr[r32] = 1.0f / l[0]; scr[32 + r32] = lam / l[1]; }
    MK_LDSFENCE();
    const float* gn = P.in[I_DNORM] + layer * 64;
    const float g0 = gn[r32] * (1.0f - lam_init), g1 = gn[32 + r32] * (1.0f - lam_init);
#pragma unroll
    for (int r = 0; r < 16; ++r) { const int q = crow(r, hi); const float i0 = scr[q], i1 = scr[32 + q];
        const float a = o[0][0][r] * i0 - o[1][0][r] * i1, c = o[0][1][r] * i0 - o[1][1][r] * i1;
        float ss = a * a + c * c;
#pragma unroll
        for (int x = 1; x < 32; x <<= 1) ss += __shfl_xor(ss, x);
        const float rs = 1.0f / sqrtf(ss * (1.0f / 64.0f) + EPS);
        bf16* op = MIX + ((size_t)b * SEQ + qw0 + q) * DM + MX_D + h * 64 + r32;
        op[0] = (bf16)f2bf(a * rs * g0); op[32] = (bf16)f2bf(c * rs * g1); }
    MK_LDSFENCE();
}
__device__ __forceinline__ void ph_diff(const Params& P, int layer, unsigned char* lds) {
    const float* tD = (const float*)(P.ws + WS_TBL + TB_D);
    for (int item = blockIdx.x; item < 256; item += gridDim.x) {
        const int bh = item >> 4, s = item & 15, b = bh >> 2, h = bh & 3;
        __syncthreads();
        for (int i = mk_tid(); i < 2048; i += NT) ((float*)(lds + 32768))[i] = tD[h * 2048 + i];
        __syncthreads();
        diff_unit(P, layer, b, h, 31 - s, lds);
        __syncthreads();
        diff_unit(P, layer, b, h, s, lds);
    }
}

__device__ __forceinline__ float gelu_tanh(float x) { const float u = 0.7978845608028654f * (x + 0.044715f * x * x * x); return 0.5f * x * (1.0f + tanhf(u)); }
template <int pass> __device__ __forceinline__ void ph_lru(const Params& P, int layer, unsigned char* lds) {
    const int tid = mk_tid(), lane = tid & 63, wid = tid >> 6, r32 = lane & 31, hi = lane >> 5;
    bf16* XC = (bf16*)lds;
    float* XCF = (float*)(lds + 16896);
    float* G0 = (float*)(lds + 16896 + 32768);
    float* G1 = G0 + 32 * 256;
    const bf16* PROJ = (const bf16*)(P.ws + WS_PROJ); bf16* MIX = (bf16*)(P.ws + WS_MIX);
    float* LSUM = (float*)(P.ws + WS_LSUM);
    const float* cw = P.in[I_LCW] + layer * 4 * 256; const float* cb = P.in[I_LCB] + layer * 256;
    const float* lam = P.in[I_LLAM] + layer * 256;
    const bf16* WT = (const bf16*)(P.ws + WS_TBL + TB_LRUW) + (size_t)layer * 2 * 4 * 64 * 64;
    const int gate = wid & 1, hb = wid >> 1;
    const float* gbias = (gate ? P.in[I_LBX] : P.in[I_LBA]) + layer * 256;
    bf16x8 wf[2][4];
#pragma unroll
    for (int nt = 0; nt < 2; ++nt)
#pragma unroll
        for (int ks = 0; ks < 4; ++ks) wf[nt][ks] = *(const bf16x8*)(WT + ((size_t)((gate * 4 + hb) * 64 + 32 * nt + r32)) * 64 + 16 * ks + 8 * hi);
    const int ch = tid & 255, tsub = tid >> 8;
    const float w0 = cw[ch], w1 = cw[256 + ch], w2 = cw[512 + ch], w3 = cw[768 + ch], cbias = cb[ch];
    const float sp = log1pf(expf(-lam[ch]));
    for (int item = blockIdx.x; item < 256; item += gridDim.x) {
        const int b = item >> 6, c = item & 63;
        const bf16* pb = PROJ + (size_t)b * SEQ * NPROJ;
        float hstate = 0.f, aprod = 1.f;
        if (pass == 1 && tid < 256) { const float* S = LSUM + (size_t)(b * 64) * 512; for (int j = 0; j < c; ++j) hstate = S[j * 512 + ch] * hstate + S[j * 512 + 256 + ch]; }
        for (int sc = 0; sc < 4; ++sc) {
            const int tl0 = c * 128 + sc * 32;
#pragma unroll 4
            for (int i = 0; i < 16; ++i) { const int tok = tsub + 2 * i, t = tl0 + tok; float acc = cbias;
                const bf16* xp = pb + (size_t)t * NPROJ + PB_X + ch;
                if (t >= 3) acc += w0 * bf2f(xp[-3 * NPROJ]);
                if (t >= 2) acc += w1 * bf2f(xp[-2 * NPROJ]);
                if (t >= 1) acc += w2 * bf2f(xp[-1 * NPROJ]);
                acc += w3 * bf2f(xp[0]);
                XCF[tok * 256 + ch] = acc; XC[tok * 264 + ch] = (bf16)f2bf(acc); }
            __syncthreads();
            { f32x16 acc[2]; acc[0] = f32x16{}; acc[1] = f32x16{};
#pragma unroll
              for (int ks = 0; ks < 4; ++ks) { const bf16x8 a = *(const bf16x8*)(XC + r32 * 264 + hb * 64 + 16 * ks + 8 * hi); acc[0] = mfma32(a, wf[0][ks], acc[0]); acc[1] = mfma32(a, wf[1][ks], acc[1]); }
              float* G = gate ? G1 : G0;
#pragma unroll
              for (int nt = 0; nt < 2; ++nt) { const int chn = hb * 64 + 32 * nt + r32; const float bi = gbias[chn];
#pragma unroll
                  for (int r = 0; r < 16; ++r) { const float v = acc[nt][r] + bi; G[crow(r, hi) * 256 + chn] = 1.0f / (1.0f + expf(-v)); } } }
            __syncthreads();
#pragma unroll 4
            for (int i = 0; i < 16; ++i) { const int idx = (tsub + 2 * i) * 256 + ch; const float r = G0[idx], ig = G1[idx];
                const float la = -8.0f * r * sp; const float a = expf(la); const float bb = sqrtf(fmaxf(-expm1f(2.0f * la), 0.f)) * (ig * XCF[idx]); G0[idx] = a; G1[idx] = bb; }
            __syncthreads();
            if (tid < 256) { for (int tok = 0; tok < 32; ++tok) { const float a = G0[tok * 256 + ch]; hstate = a * hstate + G1[tok * 256 + ch]; G1[tok * 256 + ch] = hstate; aprod *= a; } }
            __syncthreads();
            if (pass == 1) {
#pragma unroll 4
                for (int i = 0; i < 16; ++i) { const int tok = tsub + 2 * i; const size_t row = (size_t)b * SEQ + tl0 + tok;
                    const float g = bf2f(PROJ[row * NPROJ + PB_G + ch]); MIX[row * DM + MX_B + ch] = (bf16)f2bf(gelu_tanh(g) * G1[tok * 256 + ch]); }
            }
            __syncthreads();
        }
        if (pass == 0 && tid < 256) { LSUM[(size_t)(b * 64 + c) * 512 + ch] = aprod; LSUM[(size_t)(b * 64 + c) * 512 + 256 + ch] = hstate; }
    }
}

__device__ __forceinline__ float softplusf(float v) { return v > 20.f ? v : log1pf(expf(v)); }
template <int pass> __device__ __forceinline__ void ph_ssd(const Params& P, int layer, unsigned char* lds) {
    const int tid = mk_tid(), lane = tid & 63, wid = tid >> 6, r32 = lane & 31, hi = lane >> 5;
    constexpr int LD = 136;
    bf16* R0 = (bf16*)lds; bf16* R1 = (bf16*)(lds + 34816); bf16* R2 = (bf16*)(lds + 2 * 34816); bf16* R3 = (bf16*)(lds + 3 * 34816);
    float* dtv = (float*)(lds + 4 * 34816); float* acum = dtv + 256; float* wsc = acum + 256;
    float* YB = (float*)lds;
    const bf16* PROJ = (const bf16*)(P.ws + WS_PROJ); bf16* MIX = (bf16*)(P.ws + WS_MIX);
    const float* DT = (const float*)(P.ws + WS_DT); float* ST = (float*)(P.ws + WS_ST); float* CD = (float*)(P.ws + WS_CDEC);
    const float* cw = P.in[I_SCW] + layer * 4 * 768; const float* cb = P.in[I_SCB] + layer * 768;
    for (int item = blockIdx.x; item < 512; item += gridDim.x) {
        const int g = item & 1, c = (item >> 1) & 63, b = item >> 7, t0 = c * 128; const size_t rowb = (size_t)b * SEQ;
        __syncthreads();
        if (tid < 256) { const int s = tid >> 1, hl = tid & 1, hh = 2 * g + hl; dtv[tid] = softplusf(DT[(rowb + t0 + s) * 4 + hh] + P.in[I_SDTB][layer * 4 + hh]); }
        __syncthreads();
        if (tid < 2) { const float a = -expf(P.in[I_SALOG][layer * 4 + 2 * g + tid]); float run = 0.f; for (int s = 0; s < 128; ++s) { run += dtv[s * 2 + tid] * a; acum[s * 2 + tid] = run; } }
        __syncthreads();
        if (tid < 256) wsc[tid] = dtv[tid] * expf(acum[254 + (tid & 1)] - acum[tid]);
        __syncthreads();
        const int nch = pass == 0 ? 256 : 384;
        for (int idx = tid; idx < 128 * nch; idx += NT) {
            const int cc = idx % nch, s = idx / nch, t = t0 + s;
            const int col = cc < 128 ? g * 128 + cc : (cc < 256 ? 256 + g * 128 + (cc - 128) : 512 + g * 128 + (cc - 256));
            const bf16* xp = PROJ + (rowb + t) * NPROJ + PC_XBC + col;
            float acc = cb[col];
            if (t >= 3) acc += cw[col] * bf2f(xp[-3 * NPROJ]);
            if (t >= 2) acc += cw[768 + col] * bf2f(xp[-2 * NPROJ]);
            if (t >= 1) acc += cw[1536 + col] * bf2f(xp[-1 * NPROJ]);
            acc += cw[2304 + col] * bf2f(xp[0]);
            const float v = acc / (1.0f + expf(-acc));
            if (pass == 0) { if (cc < 128) R0[cc * LD + s] = (bf16)f2bf(v * wsc[s * 2 + (cc >> 6)]); else R1[(cc - 128) * LD + s] = (bf16)f2bf(v); }
            else { if (cc < 128) R2[cc * LD + s] = (bf16)f2bf(v); else if (cc < 256) R1[s * LD + (cc - 128)] = (bf16)f2bf(v); else R0[s * LD + (cc - 256)] = (bf16)f2bf(v); }
        }
        const int mt = wid >> 1, nt0 = 2 * (wid & 1);
        if (pass == 0) {
            __syncthreads();
            f32x16 acc[2]; acc[0] = f32x16{}; acc[1] = f32x16{};
#pragma unroll
            for (int ks = 0; ks < 8; ++ks) { const bf16x8 a = *(const bf16x8*)(R0 + (32 * mt + r32) * LD + 16 * ks + 8 * hi);
                acc[0] = mfma32(a, *(const bf16x8*)(R1 + (32 * nt0 + r32) * LD + 16 * ks + 8 * hi), acc[0]);
                acc[1] = mfma32(a, *(const bf16x8*)(R1 + (32 * (nt0 + 1) + r32) * LD + 16 * ks + 8 * hi), acc[1]); }
#pragma unroll
            for (int j = 0; j < 2; ++j)
#pragma unroll
                for (int r = 0; r < 16; ++r) { const int pl = 32 * mt + crow(r, hi), hh = 2 * g + (pl >> 6); ST[((size_t)((b * 64 + c) * 4 + hh)) * 8192 + (pl & 63) * 128 + 32 * (nt0 + j) + r32] = acc[j][r]; }
            if (tid < 2) CD[(b * 64 + c) * 4 + 2 * g + tid] = expf(acum[254 + tid]);
        } else {
            for (int idx = tid; idx < 128 * 128; idx += NT) { const int n = idx & 127, pl = idx >> 7; R3[pl * LD + n] = (bf16)f2bf(ST[((size_t)((b * 64 + c) * 4 + 2 * g + (pl >> 6))) * 8192 + (pl & 63) * 128 + n]); }
            __syncthreads();
            f32x16 cbt[2], ya[2]; cbt[0] = f32x16{}; cbt[1] = f32x16{}; ya[0] = f32x16{}; ya[1] = f32x16{};
#pragma unroll
            for (int ks = 0; ks < 8; ++ks) { const bf16x8 a = *(const bf16x8*)(R0 + (32 * mt + r32) * LD + 16 * ks + 8 * hi);
                cbt[0] = mfma32(a, *(const bf16x8*)(R1 + (32 * nt0 + r32) * LD + 16 * ks + 8 * hi), cbt[0]);
                cbt[1] = mfma32(a, *(const bf16x8*)(R1 + (32 * (nt0 + 1) + r32) * LD + 16 * ks + 8 * hi), cbt[1]);
                ya[0] = mfma32(a, *(const bf16x8*)(R3 + (32 * (wid & 1) + r32) * LD + 16 * ks + 8 * hi), ya[0]);
                ya[1] = mfma32(a, *(const bf16x8*)(R3 + (64 + 32 * (wid & 1) + r32) * LD + 16 * ks + 8 * hi), ya[1]); }
#pragma unroll
            for (int hl = 0; hl < 2; ++hl)
#pragma unroll
                for (int r = 0; r < 16; ++r) ya[hl][r] *= expf(acum[(32 * mt + crow(r, hi)) * 2 + hl]);
            __syncthreads();
#pragma unroll
            for (int hl = 0; hl < 2; ++hl) { bf16* dst = hl ? R0 : R1;
#pragma unroll
                for (int j = 0; j < 2; ++j)
#pragma unroll
                    for (int r = 0; r < 16; ++r) { const int lrow = 32 * mt + crow(r, hi), s = 32 * (nt0 + j) + r32;
                        const float df = acum[lrow * 2 + hl] - acum[s * 2 + hl];
                        const float v = (s <= lrow) ? cbt[j][r] * expf(fminf(df, 0.f)) * dtv[s * 2 + hl] : 0.f; dst[lrow * LD + s] = (bf16)f2bf(v); } }
            __syncthreads();
#pragma unroll
            for (int hl = 0; hl < 2; ++hl) { const bf16* Mh = hl ? R0 : R1; const int pt = 2 * hl + (wid & 1);
#pragma unroll
                for (int ks = 0; ks < 8; ++ks) ya[hl] = mfma32(*(const bf16x8*)(Mh + (32 * mt + r32) * LD + 16 * ks + 8 * hi), *(const bf16x8*)(R2 + (32 * pt + r32) * LD + 16 * ks + 8 * hi), ya[hl]); }
#pragma unroll
            for (int hl = 0; hl < 2; ++hl) { const int hh = 2 * g + hl, pl = 64 * hl + 32 * (wid & 1) + r32; const float dsk = P.in[I_SD][layer * 4 + hh];
#pragma unroll
                for (int r = 0; r < 16; ++r) { const int lrow = 32 * mt + crow(r, hi); const float xv = bf2f(R2[pl * LD + lrow]);
                    const float z = bf2f(PROJ[(rowb + t0 + lrow) * NPROJ + PC_Z + hh * 64 + (pl & 63)]); ya[hl][r] = (ya[hl][r] + dsk * xv) * (z / (1.0f + expf(-z))); } }
            __syncthreads();
#pragma unroll
            for (int hl = 0; hl < 2; ++hl) { const int pl = 64 * hl + 32 * (wid & 1) + r32;
#pragma unroll
                for (int r = 0; r < 16; ++r) YB[(32 * mt + crow(r, hi)) * 128 + pl] = ya[hl][r]; }
            __syncthreads();
            { const int lrow = tid >> 2, q = tid & 3; const float* yr = YB + lrow * 128 + 32 * q; float ss = 0.f;
#pragma unroll
              for (int e = 0; e < 32; ++e) ss += yr[e] * yr[e];
              ss += __shfl_xor(ss, 1); ss += __shfl_xor(ss, 2);
              const float rs = 1.0f / sqrtf(ss * (1.0f / 128.0f) + EPS);
              const float* gn = P.in[I_SNORM] + layer * 256 + g * 128 + 32 * q; bf16* op = MIX + (rowb + t0 + lrow) * DM + MX_C + g * 128 + 32 * q;
#pragma unroll
              for (int e = 0; e < 32; e += 2) *(unsigned*)(op + e) = pk2(yr[e] * rs * gn[e], yr[e + 1] * rs * gn[e + 1]); }
        }
    }
}
__device__ __forceinline__ void ph_ssd_scan(const Params& P) {
    float* ST = (float*)(P.ws + WS_ST); const float* CD = (const float*)(P.ws + WS_CDEC);
    for (int e = blockIdx.x * NT + mk_tid(); e < BATCH * 4 * 8192; e += gridDim.x * NT) {
        const int b = e >> 15, hh = (e >> 13) & 3, pn = e & 8191; float carry = 0.f;
        for (int c = 0; c < 64; ++c) { const size_t idx = ((size_t)((b * 64 + c) * 4 + hh)) * 8192 + pn; const float st = ST[idx]; ST[idx] = carry; carry = carry * CD[(b * 64 + c) * 4 + hh] + st; }
    }
}

constexpr int NPH = 1 + 9 * DEPTH;
__global__ void __launch_bounds__(NT, 2) mega(Params P, int ph_lo, int ph_hi) {
    extern __shared__ __attribute__((aligned(16))) unsigned char lds[];
    cooperative_groups::grid_group grid = cooperative_groups::this_grid();
    unsigned char* ws = P.ws;
    bf16* XN = (bf16*)(ws + WS_XN); bf16* PROJ = (bf16*)(ws + WS_PROJ); bf16* MIX = (bf16*)(ws + WS_MIX); bf16* HID = (bf16*)(ws + WS_HID);
    float* Y1 = (float*)(ws + WS_Y1); float* Y2 = (float*)(ws + WS_Y2); float* DT = (float*)(ws + WS_DT);
#define MK_PH(k) (ph_lo <= (k) && (k) < ph_hi)
#define MK_SEAM(k) do { if ((k) + 1 < ph_hi) grid.sync(); } while (0)
    if (MK_PH(0)) {
        ph_prep(P, lds);
        ph_row(nullptr, nullptr, P.in[I_X], nullptr, P.in[I_NMPRE], XN, P.in[I_WIN] + 2304, DT);
        MK_SEAM(0);
    }
#pragma unroll 1
    for (int layer = 0; layer < DEPTH; ++layer) {
        const int pb = 1 + 9 * layer;
        const bf16* wl = (const bf16*)(ws + WS_W + (size_t)layer * W_LAYER);
        const float* hin = layer == 0 ? P.in[I_X] : P.out;
        if (MK_PH(pb + 0)) { pg8::Gemm g{XN, wl + WO_IN / 2, MROWS, NPROJ, DM, 0}; pg8::EpiBf16R<0> e{PROJ, NPROJ, 0}; ph_gemm(g, e, lds); MK_SEAM(pb + 0); }
        if (MK_PH(pb + 1)) { ph_lru<0>(P, layer, lds); __syncthreads(); ph_ssd<0>(P, layer, lds); MK_SEAM(pb + 1); }
        if (MK_PH(pb + 2)) { ph_ssd_scan(P); MK_SEAM(pb + 2); }
        if (MK_PH(pb + 3)) { ph_diff(P, layer, lds); __syncthreads(); ph_dilated(P, lds); __syncthreads(); ph_lru<1>(P, layer, lds); __syncthreads(); ph_ssd<1>(P, layer, lds); MK_SEAM(pb + 3); }
        if (MK_PH(pb + 4)) { pg8::Gemm g{MIX, wl + WO_OUT / 2, MROWS, DM, DM, 0}; pg8::EpiF32 e{Y1, DM, 0}; ph_gemm(g, e, lds); MK_SEAM(pb + 4); }
        if (MK_PH(pb + 5)) { ph_row(Y1, P.in[I_NMPOST] + layer * DM, hin, P.out, P.in[I_NFPRE] + layer * DM, XN, nullptr, nullptr); MK_SEAM(pb + 5); }
        if (MK_PH(pb + 6)) { pg8::Gemm g{XN, wl + WO_UP / 2, MROWS, DFF, DM, 0}; pg8::EpiBf16R<2> e{HID, DFF, 0}; ph_gemm(g, e, lds); MK_SEAM(pb + 6); }
        if (MK_PH(pb + 7)) { pg8::Gemm g{HID, wl + WO_DOWN / 2, MROWS, DM, DFF, 0}; pg8::EpiF32 e{Y2, DM, 0}; ph_gemm(g, e, lds); MK_SEAM(pb + 7); }
        if (MK_PH(pb + 8)) { const bool last = layer == DEPTH - 1;
            ph_row(Y2, P.in[I_NFPOST] + layer * DM, P.out, P.out, last ? nullptr : P.in[I_NMPRE] + (layer + 1) * DM, XN, last ? nullptr : P.in[I_WIN] + (size_t)(layer + 1) * DM * PIN + 2304, DT);
            MK_SEAM(pb + 8); }
    }
}
}

#ifndef MK_N_LAUNCHES
#define MK_N_LAUNCHES 1
#endif
extern "C" void kernel_launch(void* const* d_in, const int* in_sizes, int n_in, void* d_out, int out_size, void* d_ws, size_t ws_size, hipStream_t stream) {
    using namespace mk;
    static int grid = 0;
    if (grid == 0) {
        if (n_in != N_IN || in_sizes[0] != MROWS * DM || out_size != MROWS * DM || ws_size < WS_END) {
            fprintf(stderr, "kernel_launch: unexpected shapes: n_in %d in0 %d out %d ws %zu (need %zu)\n", n_in, n_in > 0 ? in_sizes[0] : -1, out_size, ws_size, (size_t)WS_END); grid = -1; return; }
        (void)hipFuncSetAttribute((const void*)mega, hipFuncAttributeMaxDynamicSharedMemorySize, LDS_BYTES);
        int dev = 0, cus = 0, per_cu = 0;
        (void)hipGetDevice(&dev);
        (void)hipDeviceGetAttribute(&cus, hipDeviceAttributeMultiprocessorCount, dev);
        (void)hipOccupancyMaxActiveBlocksPerMultiprocessor(&per_cu, (const void*)mega, NT, LDS_BYTES);
        (void)hipGetLastError();
        if (per_cu < 1 || cus < 1) { fprintf(stderr, "kernel_launch: occupancy query: %d blocks/CU, %d CUs\n", per_cu, cus); grid = -1; return; }
        grid = cus;
    }
    if (grid < 0) return;
    Params P{};
    for (int i = 0; i < N_IN; ++i) P.in[i] = (const float*)d_in[i];
    P.out = (float*)d_out; P.ws = (unsigned char*)d_ws;
#if MK_N_LAUNCHES == 1
    int lo = 0, hi = NPH;
    void* args[] = {(void*)&P, (void*)&lo, (void*)&hi};
    hipError_t e = hipLaunchCooperativeKernel((const void*)mega, dim3(grid), dim3(NT), args, LDS_BYTES, stream);
    if (e != hipSuccess) fprintf(stderr, "kernel_launch: cooperative launch failed: %s (grid %d)\n", hipGetErrorString(e), grid);
#else
    for (int p = 0; p < NPH; ++p) hipLaunchKernelGGL(mega, dim3(grid), dim3(NT), LDS_BYTES, stream, P, p, p + 1);
#endif
}
```

```cpp
#include <hip/hip_runtime.h>
#include <cstdio>
#include <cstdint>
#include <cmath>
#include <hip/hip_cooperative_groups.h>
__device__ __forceinline__ int mk_tid() { int t = (int)threadIdx.x; asm volatile("" : "+v"(t)); return t; }
namespace pg8 {
#define PG8_LAS __attribute__((address_space(3)))
typedef unsigned short bf16_t;
typedef short bf16x8 __attribute__((ext_vector_type(8)));
typedef float f32x4 __attribute__((ext_vector_type(4)));
typedef unsigned u32x4 __attribute__((ext_vector_type(4)));
constexpr int BM = 256, BK = 64, HALF = 128, HTB = HALF * BK * 2  , STAGE_BYTES = 8 * HTB, NXCD = 8, WGM = 8;

__host__ __device__ __forceinline__ int lds_byte(int r, int c) { const int st = (r >> 4) * 2 + (c >> 5), rr = r & 15, cc = c & 31, ob = rr * 64 + cc * 2; return st * 1024 + (ob ^ (((ob >> 9) & 1) << 5)); }
__host__ __device__ __forceinline__ void stage_rc(int b, int& R, int& C) { const int st = b / 1024, sb = b % 1024, swz = sb ^ (((sb >> 9) & 1) << 5); R = (st >> 1) * 16 + swz / 64; C = (st & 1) * 32 + (swz % 64) / 2; }
__host__ __device__ __forceinline__ int perm32(int rho) { const int n = rho >> 4, i = rho & 15; return 8 * (i >> 2) + 4 * n + (i & 3); }

struct Unit { int pm, pn; };
struct Gemm { const bf16_t* A; const bf16_t* Bt; int M, N, K, pad; };

struct StaticOrder {
    int nM, nN, nwg, G, c;
    __host__ __device__ void init(int M, int N, int G_, int c_) { nM = M / BM; nN = N / BM; nwg = nM * nN; G = G_; c = c_; }
    __host__ __device__ bool next(int i, Unit& u) const {
        const long L = (long)i * G + c; if (L >= nwg) return false;
        int wgid = (int)L; { const int q = nwg / NXCD, r = nwg % NXCD, xcd = wgid % NXCD, off = wgid / NXCD; wgid = (xcd < r ? xcd * (q + 1) : r * (q + 1) + (xcd - r) * q) + off; }
        const int nig = WGM * nN, gid = wgid / nig, fm = gid * WGM, gsz = (nM - fm) < WGM ? (nM - fm) : WGM;
        u.pm = fm + ((wgid % nig) % gsz); u.pn = (wgid % nig) / gsz; return true;
    }
    __device__ __forceinline__ void a_ready(const Unit&) const {}
    __device__ __forceinline__ void done(const Unit&) const {}
};

__device__ __forceinline__ unsigned cvt_pk_bf16(float lo, float hi) { unsigned r; asm volatile("v_cvt_pk_bf16_f32 %0, %1, %2" : "=v"(r) : "v"(lo), "v"(hi)); return r; }
typedef float f32x2 __attribute__((ext_vector_type(2)));
__device__ __forceinline__ f32x2 gelu_pk(f32x2 v) {
    const f32x2 av = __builtin_elementwise_abs(v), d = av * 0.2316418882f + 1.0f;
    f32x2 t; t.x = __builtin_amdgcn_rcpf(d.x); t.y = __builtin_amdgcn_rcpf(d.y);
    f32x2 q = t * 0.5307027145f + (-0.7265760135f); q = q * t + 0.7107068705f; q = q * t + (-0.142248368f); q = q * t + 0.127414796f; q = q * t;
    const f32x2 s = (v * v) * (-0.72134752044f);
    f32x2 e; e.x = __builtin_amdgcn_exp2f(s.x); e.y = __builtin_amdgcn_exp2f(s.y);
    const f32x2 m = v * (q * e), r = v - m;
    f32x2 o; o.x = v.x < 0.f ? m.x : r.x; o.y = v.y < 0.f ? m.y : r.y; return o;
}

template <int ACT  > struct EpiBf16 {
    static constexpr bool PERM = true, AFTER_DRAIN = false; static_assert(ACT == 0 || ACT == 1, "EpiBf16: ACT is 0 (none) or 1 (gelu_pk)");
    bf16_t* O; int ldc; const float* bias; int split_cols; size_t split_stride; float scale0;
    __device__ __forceinline__ void operator()(const f32x4 (&acc)[2][2][4][2], const Unit& u, int wr, int wc, int fr, int fq) const {
        const int row0 = u.pm * BM + wr * 64 + fr; int colt = u.pn * BM; bf16_t* base = O;
        float sc = 1.f; if (split_cols) { const int t = colt / split_cols; base += (size_t)t * split_stride; colt -= t * split_cols; if (t == 0) sc = scale0; }
        const int col0 = colt + wc * 32 + 8 * fq, bcol0 = u.pn * BM + wc * 32 + 8 * fq;
        f32x4 bv[2][2];
#pragma unroll
        for (int bj = 0; bj < 2; ++bj)
#pragma unroll
            for (int n = 0; n < 2; ++n) bv[bj][n] = bias ? *(const f32x4*)(bias + bcol0 + bj * HALF + 4 * n) : (f32x4){0.f, 0.f, 0.f, 0.f};
#pragma unroll
        for (int ai = 0; ai < 2; ++ai)
#pragma unroll
            for (int m = 0; m < 4; ++m) { bf16_t* rowp = base + (size_t)(row0 + ai * HALF + m * 16) * ldc + col0;
#pragma unroll
                for (int bj = 0; bj < 2; ++bj) { f32x4 v0 = acc[ai][bj][m][0] + bv[bj][0], v1 = acc[ai][bj][m][1] + bv[bj][1];
                    if (ACT == 1) { f32x2 a = gelu_pk((f32x2){v0[0], v0[1]}), b = gelu_pk((f32x2){v0[2], v0[3]}), c = gelu_pk((f32x2){v1[0], v1[1]}), d = gelu_pk((f32x2){v1[2], v1[3]});
                        v0 = (f32x4){a.x, a.y, b.x, b.y}; v1 = (f32x4){c.x, c.y, d.x, d.y}; }
                    v0 = v0 * sc; v1 = v1 * sc; u32x4 w; w.x = cvt_pk_bf16(v0[0], v0[1]); w.y = cvt_pk_bf16(v0[2], v0[3]); w.z = cvt_pk_bf16(v1[0], v1[1]); w.w = cvt_pk_bf16(v1[2], v1[3]);
                    *(u32x4*)(rowp + bj * HALF) = w; } }
    }
};

struct PanelStats {
    unsigned* xbuf;
    unsigned* cnt;
    unsigned* tmo;
    int ntn; float eps;
    unsigned code;
    __device__ __forceinline__ bool run(const f32x4 (&v)[2][2][4][2], const Unit& u, int wr, int wc, int fr, int fq, PG8_LAS unsigned char* lds, int wid, int lane) const {
        typedef float f32x2v __attribute__((ext_vector_type(2)));
        PG8_LAS f32x2v* P = (PG8_LAS f32x2v*)lds;
        PG8_LAS f32x2v* S = (PG8_LAS f32x2v*)(lds + 8192);
        PG8_LAS unsigned* flag = (PG8_LAS unsigned*)(lds + 8192 + 2048);
#pragma unroll
        for (int ai = 0; ai < 2; ++ai)
#pragma unroll
            for (int m = 0; m < 4; ++m) {
                float s = 0.f;
#pragma unroll
                for (int bj = 0; bj < 2; ++bj)
#pragma unroll
                    for (int n = 0; n < 2; ++n) { const f32x4 x = v[ai][bj][m][n]; s += (x[0] + x[1]) + (x[2] + x[3]); }
                s += __shfl_xor(s, 16); s += __shfl_xor(s, 32);
                const float mw = s * (1.0f / 64.0f); float q = 0.f;
#pragma unroll
                for (int bj = 0; bj < 2; ++bj)
#pragma unroll
                    for (int n = 0; n < 2; ++n) { const f32x4 d = v[ai][bj][m][n] - mw; q += (d[0] * d[0] + d[1] * d[1]) + (d[2] * d[2] + d[3] * d[3]); }
                q += __shfl_xor(q, 16); q += __shfl_xor(q, 32);
                if (fq == 0) P[(ai * HALF + wr * 64 + m * 16 + fr) * 4 + wc] = (f32x2v){mw, q};
            }
        asm volatile("s_waitcnt lgkmcnt(0)" ::: "memory"); __builtin_amdgcn_s_barrier(); asm volatile("" ::: "memory");
#if defined(BROKEN_EXCHANGE_NO_WAIT)
#warning BROKEN CONTROL BUILD: the row-statistics exchange does not wait; results are wrong by design
        if (blockIdx.x >= 64) { const long long t0_ = clock64(); while (clock64() - t0_ < 60000) __builtin_amdgcn_s_sleep(8); }
#endif
        const int row = wid * 32 + (lane & 31);
        if (lane < 32) {
            const f32x2v a = P[row * 4 + 0], b = P[row * 4 + 1], c = P[row * 4 + 2], d = P[row * 4 + 3];
            const float mt = (a.x + b.x + c.x + d.x) * 0.25f;
            const float da = a.x - mt, db = b.x - mt, dc = c.x - mt, dd = d.x - mt;
            const float m2 = (a.y + b.y) + (c.y + d.y) + 64.0f * ((da * da + db * db) + (dc * dc + dd * dd));
            unsigned long long* slot = (unsigned long long*)xbuf + ((size_t)(u.pm * BM + row) * 4 + u.pn);
            __hip_atomic_store(slot, ((unsigned long long)__float_as_uint(m2) << 32) | __float_as_uint(mt), __ATOMIC_RELAXED, __HIP_MEMORY_SCOPE_AGENT);
        }
        asm volatile("s_waitcnt vmcnt(0)" ::: "memory");
        if (lane == 0) __hip_atomic_fetch_add(cnt + 64 * u.pm, 1u, __ATOMIC_RELAXED, __HIP_MEMORY_SCOPE_AGENT);
        if (wid == 0) {
            bool dead = false; const unsigned long long t0 = __builtin_amdgcn_s_memrealtime(); const unsigned want = 8u * (unsigned)ntn;
            for (;;) {
#if defined(BROKEN_EXCHANGE_NO_WAIT)
                break;
#endif
                if ((unsigned)__builtin_amdgcn_readfirstlane(__hip_atomic_load(cnt + 64 * u.pm, __ATOMIC_RELAXED, __HIP_MEMORY_SCOPE_AGENT)) >= want) break;
                if (__builtin_amdgcn_s_memrealtime() - t0 > 2000000ull) {
                    if (lane == 0) { unsigned expect = 0u; __hip_atomic_compare_exchange_strong(tmo + 1, &expect, code | (unsigned)(u.pm & 0xff), __ATOMIC_RELAXED, __ATOMIC_RELAXED, __HIP_MEMORY_SCOPE_AGENT);
                                     __hip_atomic_store(tmo, 1u, __ATOMIC_RELAXED, __HIP_MEMORY_SCOPE_AGENT); }
                    dead = true; break; }
                __builtin_amdgcn_s_sleep(2);
            }
            __builtin_amdgcn_fence(__ATOMIC_ACQUIRE, "agent");
            if (lane == 0) flag[0] = dead ? 1u : 0u;
        }
        asm volatile("s_waitcnt vmcnt(0) lgkmcnt(0)" ::: "memory"); __builtin_amdgcn_s_barrier(); asm volatile("" ::: "memory");
        const bool bad = flag[0] != 0u;
        if (lane < 32) {
            const unsigned long long* slot = (const unsigned long long*)xbuf + (size_t)(u.pm * BM + row) * 4; float mt[4], m2[4]; float ms = 0.f;
#pragma unroll
            for (int t = 0; t < 4; ++t) { if (t < ntn) { const unsigned long long w = __hip_atomic_load(slot + t, __ATOMIC_RELAXED, __HIP_MEMORY_SCOPE_AGENT); mt[t] = __uint_as_float((unsigned)w); m2[t] = __uint_as_float((unsigned)(w >> 32)); } else { mt[t] = 0.f; m2[t] = 0.f; } ms += mt[t]; }
            const float mean = ms / (float)ntn; float q = 0.f;
#pragma unroll
            for (int t = 0; t < 4; ++t) if (t < ntn) { const float dm = mt[t] - mean; q += m2[t] + 256.0f * dm * dm; }
            S[row] = (f32x2v){mean, 1.0f / sqrtf(q / (256.0f * (float)ntn) + eps)};
        }
        asm volatile("s_waitcnt lgkmcnt(0)" ::: "memory"); __builtin_amdgcn_s_barrier(); asm volatile("" ::: "memory");
        return bad;
    }
};
struct EpiLnRes {
    static constexpr bool PERM = false, AFTER_DRAIN = true;
    const float* base; float* out; int ldc; const float* bias; PanelStats st; unsigned poison;
    __device__ __forceinline__ void fused(f32x4 (&acc)[2][2][4][2], const Unit& u, int wr, int wc, int fr, int fq, PG8_LAS unsigned char* lds, int wid, int lane) const {
        typedef float f32x2v __attribute__((ext_vector_type(2)));
        const PG8_LAS f32x2v* S = (const PG8_LAS f32x2v*)(lds + 8192);
        const int col0 = u.pn * BM + wc * 32 + 4 * fq;
#pragma unroll
        for (int bj = 0; bj < 2; ++bj)
#pragma unroll
            for (int n = 0; n < 2; ++n) { const f32x4 bv = bias ? *(const f32x4*)(bias + col0 + bj * HALF + n * 16) : (f32x4){0.f, 0.f, 0.f, 0.f};
#pragma unroll
                for (int ai = 0; ai < 2; ++ai)
#pragma unroll
                    for (int m = 0; m < 4; ++m) acc[ai][bj][m][n] += bv; }
        f32x4 pre[4][2][2];
#pragma unroll
        for (int m = 0; m < 4; ++m) { const size_t off = (size_t)(u.pm * BM + wr * 64 + m * 16 + fr) * ldc + col0;
#pragma unroll
            for (int bj = 0; bj < 2; ++bj)
#pragma unroll
                for (int n = 0; n < 2; ++n) pre[m][bj][n] = *(const f32x4*)(base + off + bj * HALF + n * 16); }
        const bool bad = st.run(acc, u, wr, wc, fr, fq, lds, wid, lane) || poison != 0u;
        const float qnan = __builtin_nanf("");
#pragma unroll
        for (int ai = 0; ai < 2; ++ai)
#pragma unroll
            for (int m = 0; m < 4; ++m) { const int r = ai * HALF + wr * 64 + m * 16 + fr; const f32x2v sr = S[r]; const size_t off = (size_t)(u.pm * BM + r) * ldc + col0;
#pragma unroll
                for (int bj = 0; bj < 2; ++bj)
#pragma unroll
                    for (int n = 0; n < 2; ++n) { const f32x4 bs = ai == 0 ? pre[m][bj][n] : *(const f32x4*)(base + off + bj * HALF + n * 16); f32x4 o = bs + (acc[ai][bj][m][n] - sr.x) * sr.y;
                        if (bad) o = (f32x4){qnan, qnan, qnan, qnan}; *(f32x4*)(out + off + bj * HALF + n * 16) = o; }
                if (m & 1) asm volatile("" ::: "memory"); }
    }
};
struct EpiLnResLn {
    static constexpr bool PERM = false, AFTER_DRAIN = true;
    const float* base; float* out; bf16_t* xn; int ldc; const float* bias; PanelStats st1, st2; unsigned poison;
    __device__ __forceinline__ void fused(f32x4 (&acc)[2][2][4][2], const Unit& u, int wr, int wc, int fr, int fq, PG8_LAS unsigned char* lds, int wid, int lane) const {
        typedef float f32x2v __attribute__((ext_vector_type(2))); typedef unsigned u32x2v __attribute__((ext_vector_type(2)));
        const PG8_LAS f32x2v* S = (const PG8_LAS f32x2v*)(lds + 8192);
        const int col0 = u.pn * BM + wc * 32 + 4 * fq;
#pragma unroll
        for (int bj = 0; bj < 2; ++bj)
#pragma unroll
            for (int n = 0; n < 2; ++n) { const f32x4 bv = bias ? *(const f32x4*)(bias + col0 + bj * HALF + n * 16) : (f32x4){0.f, 0.f, 0.f, 0.f};
#pragma unroll
                for (int ai = 0; ai < 2; ++ai)
#pragma unroll
                    for (int m = 0; m < 4; ++m) acc[ai][bj][m][n] += bv; }
        bool bad = st1.run(acc, u, wr, wc, fr, fq, lds, wid, lane) || poison != 0u;
        const float qnan = __builtin_nanf("");
#pragma unroll
        for (int ai = 0; ai < 2; ++ai)
#pragma unroll
            for (int m = 0; m < 4; ++m) { const int r = ai * HALF + wr * 64 + m * 16 + fr; const f32x2v sr = S[r]; const size_t off = (size_t)(u.pm * BM + r) * ldc + col0;
#pragma unroll
                for (int bj = 0; bj < 2; ++bj)
#pragma unroll
                    for (int n = 0; n < 2; ++n) { const f32x4 bs = *(const f32x4*)(base + off + bj * HALF + n * 16); acc[ai][bj][m][n] = bs + (acc[ai][bj][m][n] - sr.x) * sr.y; }
                asm volatile("" : "+v"(acc[ai][0][m][0]), "+v"(acc[ai][0][m][1]), "+v"(acc[ai][1][m][0]), "+v"(acc[ai][1][m][1]));
                if (m & 1) asm volatile("" ::: "memory"); }
        const bool bad1 = bad;
        bad = st2.run(acc, u, wr, wc, fr, fq, lds, wid, lane) || bad;
#pragma unroll
        for (int ai = 0; ai < 2; ++ai)
#pragma unroll
            for (int m = 0; m < 4; ++m) { const int r = ai * HALF + wr * 64 + m * 16 + fr; const f32x2v sr = S[r]; const size_t off = (size_t)(u.pm * BM + r) * ldc + col0;
#pragma unroll
                for (int bj = 0; bj < 2; ++bj)
#pragma unroll
                    for (int n = 0; n < 2; ++n) { const f32x4 x1 = acc[ai][bj][m][n]; *(f32x4*)(out + off + bj * HALF + n * 16) = bad1 ? (f32x4){qnan, qnan, qnan, qnan} : x1;
                        const f32x4 o = (x1 - sr.x) * sr.y; u32x2v w; w.x = cvt_pk_bf16(o[0], o[1]); w.y = cvt_pk_bf16(o[2], o[3]);
                        if (bad) { w.x = 0x7fc07fc0u; w.y = 0x7fc07fc0u; } *(u32x2v*)(xn + off + bj * HALF + n * 16) = w; }
                asm volatile("" ::: "memory"); }
    }
};

template <class Epi, class Sched, bool ALIGN_EPI = false, bool SP2 = false>
__device__ __forceinline__ void gemm_phase(PG8_LAS unsigned char* lds, const Gemm g, const Sched& S, const Epi& E) {
    const int tid = mk_tid(), wid = __builtin_amdgcn_readfirstlane(tid >> 6), lane = tid & 63, wr = wid >> 2, wc = wid & 3, fr = lane & 15, fq = lane >> 4;
    const int K = g.K, nt = K / BK;
    unsigned voffA[2], voffB[2];
#pragma unroll
    for (int i = 0; i < 2; ++i) { int R, C; stage_rc(tid * 16 + i * 8192, R, C); const int Rb = Epi::PERM ? ((R & ~31) + perm32(R & 31)) : R;
        voffA[i] = (unsigned)(R * K + C) * 2u; voffB[i] = (unsigned)(Rb * K + C) * 2u; }
    const size_t kstep = (size_t)(BK * 2);
    const size_t hstep = (size_t)HALF * K * 2;
    const size_t tstep = 2 * hstep;
    const unsigned ldsw = (unsigned)wid * 1024u;
    const int aoff = lds_byte(wr * 64 + fr, fq * 8), boff = lds_byte(wc * 32 + fr, fq * 8);
#define PG8_SA(b, h) (((b) * 2 + (h)) * HTB)
#define PG8_SB(b, h) ((4 + (b) * 2 + (h)) * HTB)
#define PG8_STAGE(bufoff, gbase, voff) do { _Pragma("unroll") for (int _i = 0; _i < 2; ++_i) \
        __builtin_amdgcn_global_load_lds((const unsigned*)((const char*)(gbase) + (voff)[_i]), (PG8_LAS unsigned*)(lds + (bufoff) + ldsw + _i * 8192), 16, 0, 0); } while (0)
#define PG8_LDA(dst, b, h) do { _Pragma("unroll") for (int m = 0; m < 4; ++m) _Pragma("unroll") for (int k = 0; k < 2; ++k) dst[m][k] = *(const PG8_LAS bf16x8*)(lds + PG8_SA(b, h) + aoff + m * 2048 + k * 1024); } while (0)
#define PG8_LDB(dst, b, h) do { _Pragma("unroll") for (int n = 0; n < 2; ++n) _Pragma("unroll") for (int k = 0; k < 2; ++k) dst[n][k] = *(const PG8_LAS bf16x8*)(lds + PG8_SB(b, h) + boff + n * 2048 + k * 1024); } while (0)
#define PG8_MMA(ai, bj, At, Bt) do { __builtin_amdgcn_s_setprio(1); _Pragma("unroll") for (int m = 0; m < 4; ++m) _Pragma("unroll") for (int n = 0; n < 2; ++n) _Pragma("unroll") for (int k = 0; k < 2; ++k) \
        acc[ai][bj][m][n] = __builtin_amdgcn_mfma_f32_16x16x32_bf16(Bt[n][k], At[m][k], acc[ai][bj][m][n], 0, 0, 0); __builtin_amdgcn_s_setprio(0); } while (0)
#define PG8_WAIT_V(n) asm volatile("s_waitcnt vmcnt(" #n ")" ::: "memory")
#define PG8_WAIT_L(n) asm volatile("s_waitcnt lgkmcnt(" #n ")" ::: "memory")
#define PG8_BAR __builtin_amdgcn_s_barrier()
#define PG8_SCHED __builtin_amdgcn_sched_barrier(0)
    Unit cur, nxt; int ui = 0;
    if (!S.next(0, cur)) return;
    f32x4 acc[2][2][4][2];
#pragma unroll
    for (int a = 0; a < 2; ++a)
#pragma unroll
        for (int b = 0; b < 2; ++b)
#pragma unroll
            for (int m = 0; m < 4; ++m)
#pragma unroll
                for (int n = 0; n < 2; ++n) acc[a][b][m][n] = (f32x4){0.f, 0.f, 0.f, 0.f};
    bf16x8 At[4][2], B0[2][2], B1[2][2];
    const char* cA = (const char*)g.A + (size_t)cur.pm * tstep; const char* cB = (const char*)g.Bt + (size_t)cur.pn * tstep;
    S.a_ready(cur);
    if constexpr (SP2) {
        PG8_STAGE(PG8_SB(0, 0), cB, voffB); PG8_STAGE(PG8_SB(0, 1), cB + hstep, voffB); PG8_STAGE(PG8_SA(0, 0), cA, voffA); PG8_STAGE(PG8_SA(0, 1), cA + hstep, voffA);
        if (wr == 1) PG8_BAR;
        PG8_WAIT_V(2); PG8_BAR;
        PG8_STAGE(PG8_SB(1, 0), cB + kstep, voffB); PG8_STAGE(PG8_SA(1, 0), cA + kstep, voffA); PG8_STAGE(PG8_SB(1, 1), cB + hstep + kstep, voffB);
        PG8_WAIT_V(6); PG8_BAR;
    } else {
        PG8_STAGE(PG8_SB(0, 0), cB, voffB); PG8_STAGE(PG8_SA(0, 0), cA, voffA); PG8_STAGE(PG8_SB(0, 1), cB + hstep, voffB); PG8_STAGE(PG8_SA(0, 1), cA + hstep, voffA);
        if (wr == 1) PG8_BAR;
        PG8_WAIT_V(4); PG8_BAR;
        PG8_STAGE(PG8_SB(1, 0), cB + kstep, voffB); PG8_STAGE(PG8_SA(1, 0), cA + kstep, voffA); PG8_STAGE(PG8_SB(1, 1), cB + hstep + kstep, voffB);
        PG8_WAIT_V(6); PG8_BAR;
    }
    for (;;) {
        const bool has_next = S.next(ui + 1, nxt);
        const char* nA = has_next ? (const char*)g.A + (size_t)nxt.pm * tstep : cA; const char* nB = has_next ? (const char*)g.Bt + (size_t)nxt.pn * tstep : cB;
        for (int t = 0; t < nt; t += 2) {
            const bool last = (t == nt - 2);
            const char* a1 = cA + (size_t)(t + 1) * kstep;
            const char* a2 = last ? nA : cA + (size_t)(t + 2) * kstep; const char* b2 = last ? nB : cB + (size_t)(t + 2) * kstep;
            const char* a3 = a2 + kstep; const char* b3 = b2 + kstep;
            if (last && has_next) S.a_ready(nxt);
            if constexpr (SP2) {
            PG8_LDB(B0, 0, 0); PG8_LDB(B1, 0, 1); PG8_SCHED; PG8_LDA(At, 0, 0); PG8_STAGE(PG8_SA(1, 1), a1 + hstep, voffA);
            PG8_WAIT_V(8); PG8_WAIT_L(0); PG8_BAR; PG8_MMA(0, 0, At, B0); PG8_MMA(0, 1, At, B1); PG8_BAR; PG8_SCHED;
            PG8_LDA(At, 0, 1); PG8_STAGE(PG8_SB(0, 0), b2, voffB); PG8_STAGE(PG8_SB(0, 1), b2 + hstep, voffB); PG8_STAGE(PG8_SA(0, 0), a2, voffA);
            PG8_WAIT_V(8); PG8_WAIT_L(0); PG8_BAR; PG8_MMA(1, 0, At, B0); PG8_MMA(1, 1, At, B1); PG8_BAR; PG8_SCHED;
            PG8_LDB(B0, 1, 0); PG8_LDB(B1, 1, 1); PG8_SCHED; PG8_LDA(At, 1, 0); PG8_STAGE(PG8_SA(0, 1), a2 + hstep, voffA);
            PG8_WAIT_V(8); PG8_WAIT_L(0); PG8_BAR; PG8_MMA(0, 0, At, B0); PG8_MMA(0, 1, At, B1); PG8_BAR; PG8_SCHED;
            PG8_LDA(At, 1, 1); PG8_STAGE(PG8_SB(1, 0), b3, voffB); PG8_STAGE(PG8_SB(1, 1), b3 + hstep, voffB); PG8_STAGE(PG8_SA(1, 0), a3, voffA);
            PG8_WAIT_V(8); PG8_WAIT_L(0); PG8_BAR; PG8_MMA(1, 0, At, B0); PG8_MMA(1, 1, At, B1); PG8_BAR; PG8_SCHED;
            } else {
            PG8_LDB(B0, 0, 0); PG8_SCHED; PG8_LDA(At, 0, 0); PG8_STAGE(PG8_SA(1, 1), a1 + hstep, voffA);
            PG8_WAIT_L(8); PG8_BAR; PG8_WAIT_L(0); PG8_MMA(0, 0, At, B0); PG8_BAR; PG8_SCHED;
            PG8_LDB(B1, 0, 1); PG8_STAGE(PG8_SB(0, 0), b2, voffB);
            PG8_BAR; PG8_WAIT_L(0); PG8_MMA(0, 1, At, B1); PG8_BAR;
            PG8_LDA(At, 0, 1); PG8_STAGE(PG8_SA(0, 0), a2, voffA);
            PG8_BAR; PG8_WAIT_L(0); PG8_MMA(1, 0, At, B0); PG8_BAR; PG8_SCHED;
            PG8_STAGE(PG8_SB(0, 1), b2 + hstep, voffB);
            PG8_WAIT_V(6); PG8_BAR; PG8_MMA(1, 1, At, B1); PG8_BAR;
            PG8_LDB(B0, 1, 0); PG8_SCHED; PG8_LDA(At, 1, 0); PG8_STAGE(PG8_SA(0, 1), a2 + hstep, voffA);
            PG8_WAIT_L(8); PG8_BAR; PG8_WAIT_L(0); PG8_MMA(0, 0, At, B0); PG8_BAR; PG8_SCHED;
            PG8_LDB(B1, 1, 1); PG8_STAGE(PG8_SB(1, 0), b3, voffB);
            PG8_BAR; PG8_WAIT_L(0); PG8_MMA(0, 1, At, B1); PG8_BAR;
            PG8_LDA(At, 1, 1); PG8_STAGE(PG8_SA(1, 0), a3, voffA);
            PG8_BAR; PG8_WAIT_L(0); PG8_MMA(1, 0, At, B0); PG8_BAR; PG8_SCHED;
            PG8_STAGE(PG8_SB(1, 1), b3 + hstep, voffB);
            PG8_WAIT_V(6); PG8_BAR; PG8_MMA(1, 1, At, B1); PG8_BAR;
            }
        }
        if constexpr (ALIGN_EPI) { if (wr == 0) PG8_BAR; }
        if constexpr (!Epi::AFTER_DRAIN) { E(acc, cur, wr, wc, fr, fq); S.done(cur); }
        if (!has_next) break;
#pragma unroll
        for (int a = 0; a < 2; ++a)
#pragma unroll
            for (int b = 0; b < 2; ++b)
#pragma unroll
                for (int m = 0; m < 4; ++m)
#pragma unroll
                    for (int n = 0; n < 2; ++n) acc[a][b][m][n] = (f32x4){0.f, 0.f, 0.f, 0.f};
        cur = nxt; cA = nA; cB = nB; ++ui;
        if constexpr (ALIGN_EPI) { if (wr == 1) PG8_BAR; }
    }
    PG8_WAIT_V(0);
    if constexpr (!ALIGN_EPI) { if (wr == 0) PG8_BAR; }
    PG8_BAR;
    if constexpr (Epi::AFTER_DRAIN) { E.fused(acc, cur, wr, wc, fr, fq, lds, wid, lane); S.done(cur); }
#undef PG8_SA
#undef PG8_SB
#undef PG8_STAGE
#undef PG8_LDA
#undef PG8_LDB
#undef PG8_MMA
#undef PG8_WAIT_V
#undef PG8_WAIT_L
#undef PG8_BAR
#undef PG8_SCHED
}
}

namespace pg8 {
template <int ACT> struct EpiBf16R {
    static constexpr bool PERM = true, AFTER_DRAIN = false;
    bf16_t* O; int ldc, pad;
    __device__ __forceinline__ void operator()(const f32x4 (&acc)[2][2][4][2], const Unit& u, int wr, int wc, int fr, int fq) const {
        const int row0 = u.pm * BM + wr * 64 + fr; const int col0 = u.pn * BM + wc * 32 + 8 * fq;
#pragma unroll
        for (int ai = 0; ai < 2; ++ai)
#pragma unroll
            for (int m = 0; m < 4; ++m) { bf16_t* rowp = O + (size_t)(row0 + ai * HALF + m * 16) * ldc + col0;
#pragma unroll
                for (int bj = 0; bj < 2; ++bj) { f32x4 v0 = acc[ai][bj][m][0], v1 = acc[ai][bj][m][1];
                    if (ACT == 2) {
#pragma unroll
                        for (int e = 0; e < 4; ++e) { float a = v0[e] > 0.f ? v0[e] : 0.f; v0[e] = a * a; float b = v1[e] > 0.f ? v1[e] : 0.f; v1[e] = b * b; } }
                    u32x4 w; w.x = cvt_pk_bf16(v0[0], v0[1]); w.y = cvt_pk_bf16(v0[2], v0[3]); w.z = cvt_pk_bf16(v1[0], v1[1]); w.w = cvt_pk_bf16(v1[2], v1[3]);
                    *(u32x4*)(rowp + bj * HALF) = w; } }
    }
};
struct EpiF32 {
    static constexpr bool PERM = false, AFTER_DRAIN = false;
    float* O; int ldc, pad;
    __device__ __forceinline__ void operator()(const f32x4 (&acc)[2][2][4][2], const Unit& u, int wr, int wc, int fr, int fq) const {
        const int col0 = u.pn * BM + wc * 32 + 4 * fq;
#pragma unroll
        for (int ai = 0; ai < 2; ++ai)
#pragma unroll
            for (int m = 0; m < 4; ++m) { const size_t off = (size_t)(u.pm * BM + ai * HALF + wr * 64 + m * 16 + fr) * ldc + col0;
#pragma unroll
                for (int bj = 0; bj < 2; ++bj)
#pragma unroll
                    for (int n = 0; n < 2; ++n) *(f32x4*)(O + off + bj * HALF + n * 16) = acc[ai][bj][m][n]; }
    }
};
}

namespace mk {
typedef unsigned short bf16;
typedef short bf16x8 __attribute__((ext_vector_type(8)));
typedef short s16x4 __attribute__((ext_vector_type(4)));
typedef float f32x4 __attribute__((ext_vector_type(4)));
typedef float f32x16 __attribute__((ext_vector_type(16)));
typedef unsigned u32x4 __attribute__((ext_vector_type(4)));
typedef unsigned u32x2 __attribute__((ext_vector_type(2)));
#define MK_LAS __attribute__((address_space(3)))

constexpr int BATCH = 4, SEQ = 8192, DM = 1024, DFF = 4096, MROWS = BATCH * SEQ, NPROJ = 3072, PIN = 3076, DEPTH = 2, NT = 512;
constexpr float EPS = 1e-6f, LOG2E = 1.4426950408889634f, NEGS = -30000.f, MINIT = -10000.f;
constexpr int PA_Q = 0, PA_K = 256, PA_V = 512, PB_G = 768, PB_X = 1024, PC_Z = 1280, PC_XBC = 1536, PD_Q = 2304, PD_K = 2560, PD_V = 2816;
constexpr int MX_A = 0, MX_B = 256, MX_C = 512, MX_D = 768;

constexpr size_t MiB = 1u << 20;
constexpr size_t WS_CTL = 0, WS_TBL = 1 * MiB, WS_W = 2 * MiB, W_LAYER = 24 * MiB, WS_DT = 52 * MiB, WS_LSUM = 53 * MiB, WS_CDEC = 54 * MiB,
                 WS_XN = 64 * MiB, WS_PROJ = 128 * MiB, WS_MIX = 320 * MiB, WS_HID = 128 * MiB, WS_Y1 = 128 * MiB, WS_Y2 = 384 * MiB, WS_ST = 384 * MiB, WS_CONV = 448 * MiB, WS_END = 512 * MiB;
constexpr size_t WO_IN = 0, WO_OUT = 6 * MiB, WO_UP = 8 * MiB, WO_DOWN = 16 * MiB;
constexpr size_t TB_D = 0  , TB_A = 32768  , TB_LAM = 40960  , TB_LRUW = 65536  ;
constexpr int LDS_BYTES = 147456;

enum { I_X = 0, I_RELB, I_NMPRE, I_NMPOST, I_NFPRE, I_NFPOST, I_WIN, I_WOUT, I_LCW, I_LCB, I_LWA, I_LBA, I_LWX, I_LBX, I_LLAM,
       I_SCW, I_SCB, I_SDTB, I_SALOG, I_SD, I_SNORM, I_LQ1, I_LK1, I_LQ2, I_LK2, I_DNORM, I_WUP, I_WDOWN, N_IN };
struct Params { const float* in[N_IN]; float* out; unsigned char* ws; };

__device__ __forceinline__ unsigned f2bf(float f) { unsigned u = __float_as_uint(f); return (u + 0x7fffu + ((u >> 16) & 1u)) >> 16; }
__device__ __forceinline__ float bf2f(unsigned short b) { return __uint_as_float(((unsigned)b) << 16); }
__device__ __forceinline__ unsigned pk2(float lo, float hi) { return f2bf(lo) | (f2bf(hi) << 16); }
__device__ __forceinline__ int crow(int r, int hi) { return (r & 3) + 8 * (r >> 2) + 4 * hi; }
__device__ __forceinline__ float wave_sum(float v) {
#pragma unroll
    for (int o = 1; o < 64; o <<= 1) v += __shfl_xor(v, o);
    return v;
}
__device__ __forceinline__ int t5_bucket(int n) {
    if (n < 16) return n;
    return 16 + (n >= 22) + (n >= 30) + (n >= 40) + (n >= 54) + (n >= 73) + (n >= 99) + (n >= 134) + (n >= 182) + (n >= 246) + (n >= 332) + (n >= 450) + (n >= 609) + (n >= 825) + (n >= 1117) + (n >= 1513);
}
__device__ __forceinline__ f32x16 mfma32(bf16x8 a, bf16x8 b, f32x16 c) { return __builtin_amdgcn_mfma_f32_32x32x16_bf16(a, b, c, 0, 0, 0); }
__device__ __forceinline__ bf16x8 pack8(const f32x16& p, int base) {
    u32x4 w; w.x = pk2(p[base + 0], p[base + 1]); w.y = pk2(p[base + 2], p[base + 3]); w.z = pk2(p[base + 4], p[base + 5]); w.w = pk2(p[base + 6], p[base + 7]);
    return __builtin_bit_cast(bf16x8, w);
}
typedef short v4i16_t __attribute__((ext_vector_type(4)));
__device__ __forceinline__ s16x4 vtr(const unsigned char* p) {
    return __builtin_bit_cast(s16x4, __builtin_amdgcn_ds_read_tr16_b64_v4i16((MK_LAS v4i16_t*)(p)));
}
__device__ __forceinline__ bf16x8 vfrag(const unsigned char* p) {
    const s16x4 lo = vtr(p), hi = vtr(p + 512);
    return (bf16x8){lo[0], lo[1], lo[2], lo[3], hi[0], hi[1], hi[2], hi[3]};
}
#define MK_LDSFENCE() asm volatile("s_waitcnt lgkmcnt(0)" ::: "memory")

__device__ __forceinline__ void tr_item(const float* W, int K, int Nsrc, bf16* WT, int k0, int n0, bool remap, float* scr, int tid) {
    const int c = tid & 63, r0 = tid >> 6;
#pragma unroll
    for (int i = 0; i < 8; ++i) { const int k = r0 + 8 * i; const int n = n0 + c; const int sn = (remap && n >= 2304) ? n + 4 : n; scr[k * 65 + c] = W[(size_t)(k0 + k) * Nsrc + sn]; }
    __syncthreads();
#pragma unroll
    for (int i = 0; i < 8; ++i) { const int n = r0 + 8 * i; WT[(size_t)(n0 + n) * K + k0 + c] = (bf16)f2bf(scr[c * 65 + n]); }
    __syncthreads();
}
__device__ __forceinline__ void ph_prep(const Params& P, unsigned char* lds) {
    float* scr = (float*)lds; const int tid = mk_tid();
    constexpr int T_IN = 16 * 48, T_OUT = 16 * 16, T_UP = 16 * 64, T_DOWN = 64 * 16, T_L = T_IN + T_OUT + T_UP + T_DOWN;
    for (int it = blockIdx.x; it < DEPTH * T_L; it += gridDim.x) {
        const int layer = it / T_L; int r = it % T_L; bf16* wl = (bf16*)(P.ws + WS_W + (size_t)layer * W_LAYER);
        if (r < T_IN) { tr_item(P.in[I_WIN] + (size_t)layer * DM * PIN, DM, PIN, wl + WO_IN / 2, (r / 48) * 64, (r % 48) * 64, true, scr, tid); continue; } r -= T_IN;
        if (r < T_OUT) { tr_item(P.in[I_WOUT] + (size_t)layer * DM * DM, DM, DM, wl + WO_OUT / 2, (r / 16) * 64, (r % 16) * 64, false, scr, tid); continue; } r -= T_OUT;
        if (r < T_UP) { tr_item(P.in[I_WUP] + (size_t)layer * DM * DFF, DM, DFF, wl + WO_UP / 2, (r / 64) * 64, (r % 64) * 64, false, scr, tid); continue; } r -= T_UP;
        tr_item(P.in[I_WDOWN] + (size_t)layer * DFF * DM, DFF, DM, wl + WO_DOWN / 2, (r / 16) * 64, (r % 16) * 64, false, scr, tid);
    }
    const int gid = blockIdx.x * NT + tid, gn = gridDim.x * NT;
    const float* rb = P.in[I_RELB];
    float* tD = (float*)(P.ws + WS_TBL + TB_D); float* tA = (float*)(P.ws + WS_TBL + TB_A); float* tL = (float*)(P.ws + WS_TBL + TB_LAM);
    for (int i = gid; i < 4 * 2048; i += gn) { const int h = i >> 11, d = i & 2047; tD[i] = (rb[t5_bucket(d) * 8 + 4 + h] - rb[31 * 8 + 4 + h]) * LOG2E; }
    for (int i = gid; i < 3 * 4 * 132; i += gn) { const int p = i / (4 * 132), h = (i / 132) & 3, j = i % 132; const int dil = p == 0 ? 1 : (p == 1 ? 4 : 16);
        tA[i] = (j <= 128) ? rb[t5_bucket(j * dil) * 8 + h] * LOG2E : NEGS; }
    if (gid < DEPTH) { const int layer = gid; float s1 = 0.f, s2 = 0.f;
        for (int i = 0; i < 32; ++i) { s1 += P.in[I_LQ1][layer * 32 + i] * P.in[I_LK1][layer * 32 + i]; s2 += P.in[I_LQ2][layer * 32 + i] * P.in[I_LK2][layer * 32 + i]; }
        const float lam_init = 0.8f - 0.6f * expf(-0.3f * (float)layer); tL[layer] = expf(s1) - expf(s2) + lam_init; }
    bf16* lw = (bf16*)(P.ws + WS_TBL + TB_LRUW);
    for (int i = gid; i < DEPTH * 2 * 4 * 64 * 64; i += gn) { const int ii = i & 63, j = (i >> 6) & 63, hb = (i >> 12) & 3, g = (i >> 14) & 1, layer = i >> 15;
        const float* src = (g ? P.in[I_LWX] : P.in[I_LWA]) + (size_t)layer * 4 * 64 * 64; lw[i] = (bf16)f2bf(src[(hb * 64 + ii) * 64 + j]); }
}

__device__ __forceinline__ void ph_row(const float* Y, const float* gpost, const float* base, float* hout, const float* gnext, bf16* XN, const float* Wdt, float* DT) {
    const int tid_ = mk_tid(); const int lane = tid_ & 63, gw = blockIdx.x * (NT / 64) + (tid_ >> 6), ngw = gridDim.x * (NT / 64);
    for (int m = gw; m < MROWS; m += ngw) {
        f32x4 hv[4];
        const f32x4* bp = (const f32x4*)(base + (size_t)m * DM) + lane;
#pragma unroll
        for (int j = 0; j < 4; ++j) hv[j] = bp[64 * j];
        if (Y) {
            const f32x4* yp = (const f32x4*)(Y + (size_t)m * DM) + lane; f32x4 y[4]; float ss = 0.f;
#pragma unroll
            for (int j = 0; j < 4; ++j) { y[j] = yp[64 * j]; ss += (y[j].x * y[j].x + y[j].y * y[j].y) + (y[j].z * y[j].z + y[j].w * y[j].w); }
            ss = wave_sum(ss); const float r = 1.0f / sqrtf(ss * (1.0f / DM) + EPS);
            const f32x4* gp = (const f32x4*)gpost + lane; f32x4* hp = (f32x4*)(hout + (size_t)m * DM) + lane;
#pragma unroll
            for (int j = 0; j < 4; ++j) { hv[j] = hv[j] + y[j] * r * gp[64 * j]; hp[64 * j] = hv[j]; }
        }
        if (gnext) {
            float ss = 0.f;
#pragma unroll
            for (int j = 0; j < 4; ++j) ss += (hv[j].x * hv[j].x + hv[j].y * hv[j].y) + (hv[j].z * hv[j].z + hv[j].w * hv[j].w);
            ss = wave_sum(ss); const float r = 1.0f / sqrtf(ss * (1.0f / DM) + EPS);
            const f32x4* gp = (const f32x4*)gnext + lane; u32x2* xp = (u32x2*)(XN + (size_t)m * DM) + lane;
            f32x4 d = {0.f, 0.f, 0.f, 0.f};
#pragma unroll
            for (int j = 0; j < 4; ++j) { const f32x4 u = hv[j] * r * gp[64 * j]; u32x2 w; w.x = pk2(u.x, u.y); w.y = pk2(u.z, u.w); xp[64 * j] = w;
                if (Wdt) { const float* wp = Wdt + (size_t)(4 * (lane + 64 * j)) * PIN;
                    d = d + u.x * *(const f32x4*)(wp) + u.y * *(const f32x4*)(wp + PIN) + u.z * *(const f32x4*)(wp + 2 * PIN) + u.w * *(const f32x4*)(wp + 3 * PIN); } }
            if (Wdt) { d.x = wave_sum(d.x); d.y = wave_sum(d.y); d.z = wave_sum(d.z); d.w = wave_sum(d.w); if (lane == 0) *(f32x4*)(DT + (size_t)m * 4) = d; }
        }
    }
}

template <class Epi> __device__ __forceinline__ void ph_gemm(const pg8::Gemm g, const Epi e, unsigned char* lds) {
    pg8::StaticOrder S; S.init(g.M, g.N, (int)gridDim.x, (int)blockIdx.x);
    pg8::gemm_phase<Epi, pg8::StaticOrder, true, true>((PG8_LAS unsigned char*)lds, g, S, e);
}

__device__ __forceinline__ void ph_dilated(const Params& P, unsigned char* lds) {
    const int tid = mk_tid(), lane = tid & 63, wid = tid >> 6, r32 = lane & 31, hi = lane >> 5;
    float* tbl = (float*)lds;
    unsigned char* vst = lds + 13824 + wid * 4352;
    float* scr = (float*)(vst + 4096);
    const bf16* PROJ = (const bf16*)(P.ws + WS_PROJ); bf16* MIX = (bf16*)(P.ws + WS_MIX);
    const float* tA = (const float*)(P.ws + WS_TBL + TB_A);
    for (int item = blockIdx.x; item < 512; item += gridDim.x) {
        const int half = item & 1, chunk = (item >> 1) & 15, h = (item >> 5) & 3, b = item >> 7;
        __syncthreads();
        for (int i = tid; i < 3 * 1152; i += NT) { const int p = i / 1152, j = (i % 1152) - 496; tbl[i] = (j >= 0 && j <= 128) ? tA[(p * 4 + h) * 132 + j] : NEGS; }
        __syncthreads();
        const int rres = half * 8 + wid, T0 = chunk * 512, Tmax = T0 + rres + 496;
        const bf16* base = PROJ + (size_t)b * SEQ * NPROJ;
        bf16x8 qf[4];
        { const bf16* qp = base + (size_t)(T0 + rres + 16 * r32) * NPROJ + PA_Q + h * 64 + hi * 8; const float c2 = 0.125f * LOG2E;
#pragma unroll
          for (int s = 0; s < 4; ++s) { const bf16x8 q = *(const bf16x8*)(qp + 16 * s); u32x4 w;
              w.x = pk2(bf2f((bf16)q[0]) * c2, bf2f((bf16)q[1]) * c2); w.y = pk2(bf2f((bf16)q[2]) * c2, bf2f((bf16)q[3]) * c2);
              w.z = pk2(bf2f((bf16)q[4]) * c2, bf2f((bf16)q[5]) * c2); w.w = pk2(bf2f((bf16)q[6]) * c2, bf2f((bf16)q[7]) * c2); qf[s] = __builtin_bit_cast(bf16x8, w); } }
        float m = MINIT, l = 0.f; f32x16 o0 = {}, o1 = {};
        for (int p = 0; p < 3; ++p) {
            const int dl = p == 0 ? 1 : (p == 1 ? 4 : 16), rho = 16 / dl, ntile = (rho * 31 + 128) / 32 + 1, kmaxp = Tmax / dl, kq = rho * (31 - r32);
            for (int tau = 0; tau < ntile; ++tau) {
                const int k0 = 32 * tau;
                bf16x8 kf[4];
                { int pos = Tmax - dl * (k0 + r32); pos = pos < 0 ? 0 : pos; const bf16* kp = base + (size_t)pos * NPROJ + PA_K + h * 64 + hi * 8;
#pragma unroll
                  for (int s = 0; s < 4; ++s) kf[s] = *(const bf16x8*)(kp + 16 * s); }
#pragma unroll
                for (int i = 0; i < 4; ++i) { const int ci = lane + 64 * i, krow = ci >> 3, ch = ci & 7; int pos = Tmax - dl * (k0 + krow); pos = pos < 0 ? 0 : pos;
                    const bf16x8 v = *(const bf16x8*)(base + (size_t)pos * NPROJ + PA_V + h * 64 + ch * 8);
                    *(bf16x8*)(vst + ((ch >> 2) * 2 + (krow >> 4)) * 1024 + (krow & 15) * 64 + (ch & 3) * 16) = v; }
                f32x16 acc;
                { const float* tb = tbl + p * 1152 + (k0 + 4 * hi - kq + 496);
#pragma unroll
                  for (int r = 0; r < 16; ++r) acc[r] = tb[(r & 3) + 8 * (r >> 2)]; }
#pragma unroll
                for (int s = 0; s < 4; ++s) acc = mfma32(kf[s], qf[s], acc);
#pragma unroll
                for (int r = 0; r < 16; ++r) if (k0 + crow(r, hi) > kmaxp) acc[r] = NEGS;
                float mx = acc[0];
#pragma unroll
                for (int r = 1; r < 16; ++r) mx = fmaxf(mx, acc[r]);
                mx = fmaxf(mx, __shfl_xor(mx, 32));
                const float mn = fmaxf(m, mx), f = exp2f(m - mn); m = mn;
                float ps = 0.f;
#pragma unroll
                for (int r = 0; r < 16; ++r) { acc[r] = exp2f(acc[r] - mn); ps += acc[r]; }
                l = l * f + ps;
                if (__any(f != 1.0f)) {
                    if (hi == 0) scr[r32] = f;
                    MK_LDSFENCE();
#pragma unroll
                    for (int r = 0; r < 16; ++r) { const float fr = scr[crow(r, hi)]; o0[r] *= fr; o1[r] *= fr; }
                }
                MK_LDSFENCE();
                const unsigned char* vb = vst + ((lane >> 4) & 1) * 32 + (lane & 3) * 8 + (4 * hi + ((lane & 15) >> 2)) * 64;
#pragma unroll
                for (int ks = 0; ks < 2; ++ks) { const bf16x8 pa = pack8(acc, 8 * ks);
                    o0 = mfma32(pa, vfrag(vb + ks * 1024), o0); o1 = mfma32(pa, vfrag(vb + 2048 + ks * 1024), o1); }
                MK_LDSFENCE();
            }
        }
        l += __shfl_xor(l, 32);
        if (hi == 0) scr[r32] = 1.0f / l;
        MK_LDSFENCE();
#pragma unroll
        for (int r = 0; r < 16; ++r) { const int q = crow(r, hi); const float inv = scr[q];
            bf16* op = MIX + ((size_t)b * SEQ + T0 + rres + 16 * q) * DM + MX_A + h * 64 + r32;
            op[0] = (bf16)f2bf(o0[r] * inv); op[32] = (bf16)f2bf(o1[r] * inv); }
        MK_LDSFENCE();
    }
}

__device__ __forceinline__ void diff_unit(const Params& P, int layer, int b, int h, int qb, unsigned char* lds) {
    const int tid = mk_tid(), lane = tid & 63, wid = tid >> 6, r32 = lane & 31, hi = lane >> 5;
    unsigned char* Kb = lds;
    unsigned char* Vb = lds + 16384;
    const float* tbl = (const float*)(lds + 32768);
    float* scr = (float*)(lds + 40960) + wid * 64;
    const bf16* PROJ = (const bf16*)(P.ws + WS_PROJ); bf16* MIX = (bf16*)(P.ws + WS_MIX);
    const bf16* base = PROJ + (size_t)b * SEQ * NPROJ;
    const int q0 = qb * 256, qw0 = q0 + 32 * wid, qabs = qw0 + r32, NTL = 4 * qb + 4;
    bf16x8 qf[2][2];
    { const bf16* qp = base + (size_t)qabs * NPROJ + PD_Q + h * 64 + hi * 8; const float c2 = 0.17677669529663687f * LOG2E;
#pragma unroll
      for (int c = 0; c < 2; ++c)
#pragma unroll
          for (int s = 0; s < 2; ++s) { const bf16x8 q = *(const bf16x8*)(qp + c * 32 + 16 * s); u32x4 w;
              w.x = pk2(bf2f((bf16)q[0]) * c2, bf2f((bf16)q[1]) * c2); w.y = pk2(bf2f((bf16)q[2]) * c2, bf2f((bf16)q[3]) * c2);
              w.z = pk2(bf2f((bf16)q[4]) * c2, bf2f((bf16)q[5]) * c2); w.w = pk2(bf2f((bf16)q[6]) * c2, bf2f((bf16)q[7]) * c2); qf[c][s] = __builtin_bit_cast(bf16x8, w); } }
    const int lrow = tid >> 3, lch = tid & 7;
    const bf16* kg = base + (size_t)lrow * NPROJ + PD_K + h * 64 + lch * 8;
    const bf16* vg = base + (size_t)lrow * NPROJ + PD_V + h * 64 + lch * 8;
    const int kdst = lrow * 128 + ((lch ^ (lrow & 7)) * 16), vdst = ((lch >> 2) * 4 + (lrow >> 4)) * 1024 + (lrow & 15) * 64 + (lch & 3) * 16;
    { const bf16x8 k = *(const bf16x8*)kg, v = *(const bf16x8*)vg; *(bf16x8*)(Kb + kdst) = k; *(bf16x8*)(Vb + vdst) = v; }
    float m[2] = {MINIT, MINIT}, l[2] = {0.f, 0.f}; f32x16 o[2][2]; o[0][0] = f32x16{}; o[0][1] = f32x16{}; o[1][0] = f32x16{}; o[1][1] = f32x16{};
    __syncthreads();
    for (int j = 0; j < NTL; ++j) {
        bf16x8 kn = {}, vn = {};
        if (j + 1 < NTL) { kn = *(const bf16x8*)(kg + (size_t)(j + 1) * 64 * NPROJ); vn = *(const bf16x8*)(vg + (size_t)(j + 1) * 64 * NPROJ); }
        const int k0 = 64 * j;
        if (k0 <= qw0 + 31) {
            const unsigned char* Kt = Kb + (j & 1) * 8192; const unsigned char* Vt = Vb + (j & 1) * 8192;
            f32x16 sc[2][2];
            const bool near = (qw0 - k0 - 63) < 1513;
#pragma unroll
            for (int kh = 0; kh < 2; ++kh) {
                f32x16 init = {};
                if (near) { const int dq = qabs - k0 - 32 * kh - 4 * hi;
#pragma unroll
                    for (int r = 0; r < 16; ++r) { int d = dq - ((r & 3) + 8 * (r >> 2)); d = d < 0 ? 0 : d; init[r] = tbl[d]; } }
                const int key = 32 * kh + r32; const unsigned char* kr = Kt + key * 128;
#pragma unroll
                for (int c = 0; c < 2; ++c) { f32x16 a = init;
#pragma unroll
                    for (int s = 0; s < 2; ++s) { const int chunk = c * 4 + 2 * s + hi; a = mfma32(*(const bf16x8*)(kr + ((chunk ^ (key & 7)) * 16)), qf[c][s], a); }
                    sc[c][kh] = a; }
            }
            if (k0 + 63 > qw0) {
#pragma unroll
                for (int kh = 0; kh < 2; ++kh)
#pragma unroll
                    for (int r = 0; r < 16; ++r) if (k0 + 32 * kh + crow(r, hi) > qabs) { sc[0][kh][r] = NEGS; sc[1][kh][r] = NEGS; }
            }
            float fsc[2];
#pragma unroll
            for (int c = 0; c < 2; ++c) {
                float mx = sc[c][0][0];
#pragma unroll
                for (int r = 1; r < 16; ++r) mx = fmaxf(mx, sc[c][0][r]);
#pragma unroll
                for (int r = 0; r < 16; ++r) mx = fmaxf(mx, sc[c][1][r]);
                mx = fmaxf(mx, __shfl_xor(mx, 32));
                const float mn = fmaxf(m[c], mx), f = exp2f(m[c] - mn); m[c] = mn; fsc[c] = f;
                float ps = 0.f;
#pragma unroll
                for (int r = 0; r < 16; ++r) { sc[c][0][r] = exp2f(sc[c][0][r] - mn); ps += sc[c][0][r]; }
#pragma unroll
                for (int r = 0; r < 16; ++r) { sc[c][1][r] = exp2f(sc[c][1][r] - mn); ps += sc[c][1][r]; }
                l[c] = l[c] * f + ps;
            }
            if (__any(fsc[0] != 1.0f || fsc[1] != 1.0f)) {
                if (hi == 0) { scr[r32] = fsc[0]; scr[32 + r32] = fsc[1]; }
                MK_LDSFENCE();
#pragma unroll
                for (int r = 0; r < 16; ++r) { const int q = crow(r, hi); const float f0 = scr[q], f1 = scr[32 + q];
                    o[0][0][r] *= f0; o[0][1][r] *= f0; o[1][0][r] *= f1; o[1][1][r] *= f1; }
                MK_LDSFENCE();
            }
            const unsigned char* vb = Vt + ((lane >> 4) & 1) * 32 + (lane & 3) * 8 + (4 * hi + ((lane & 15) >> 2)) * 64;
#pragma unroll
            for (int ks = 0; ks < 4; ++ks) {
                const bf16x8 v0 = vfrag(vb + ks * 1024), v1 = vfrag(vb + 4096 + ks * 1024);
                const bf16x8 p0 = pack8(sc[0][ks >> 1], 8 * (ks & 1)), p1 = pack8(sc[1][ks >> 1], 8 * (ks & 1));
                o[0][0] = mfma32(p0, v0, o[0][0]); o[0][1] = mfma32(p0, v1, o[0][1]);
                o[1][0] = mfma32(p1, v0, o[1][0]); o[1][1] = mfma32(p1, v1, o[1][1]);
            }
        }
        if (j + 1 < NTL) { *(bf16x8*)(Kb + ((j + 1) & 1) * 8192 + kdst) = kn; *(bf16x8*)(Vb + ((j + 1) & 1) * 8192 + vdst) = vn; }
        __syncthreads();
    }
    const float lam = ((const float*)(P.ws + WS_TBL + TB_LAM))[layer];
    const float lam_init = 0.8f - 0.6f * expf(-0.3f * (float)layer);
    l[0] += __shfl_xor(l[0], 32); l[1] += __shfl_xor(l[1], 32);
    if (hi == 0) { scr[r32] = 1.0f / l[0]; scr[32 + r32] = lam / l[1]; }
    MK_LDSFENCE();
    const float* gn = P.in[I_DNORM] + layer * 64;
    const float g0 = gn[r32] * (1.0f - lam_init), g1 = gn[32 + r32] * (1.0f - lam_init);
#pragma unroll
    for (int r = 0; r < 16; ++r) { const int q = crow(r, hi); const float i0 = scr[q], i1 = scr[32 + q];
        const float a = o[0][0][r] * i0 - o[1][0][r] * i1, c = o[0][1][r] * i0 - o[1][1][r] * i1;
        float ss = a * a + c * c;
#pragma unroll
        for (int x = 1; x < 32; x <<= 1) ss += __shfl_xor(ss, x);
        const float rs = 1.0f / sqrtf(ss * (1.0f / 64.0f) + EPS);
        bf16* op = MIX + ((size_t)b * SEQ + qw0 + q) * DM + MX_D + h * 64 + r32;
        op[0] = (bf16)f2bf(a * rs * g0); op[32] = (bf16)f2bf(c * rs * g1); }
    MK_LDSFENCE();
}
__device__ __forceinline__ void ph_diff(const Params& P, int layer, unsigned char* lds) {
    const float* tD = (const float*)(P.ws + WS_TBL + TB_D);
    for (int item = blockIdx.x; item < 256; item += gridDim.x) {
        const int bh = item >> 4, s = item & 15, b = bh >> 2, h = bh & 3;
        __syncthreads();
        for (int i = mk_tid(); i < 2048; i += NT) ((float*)(lds + 32768))[i] = tD[h * 2048 + i];
        __syncthreads();
        diff_unit(P, layer, b, h, 31 - s, lds);
        __syncthreads();
        diff_unit(P, layer, b, h, s, lds);
    }
}

__device__ __forceinline__ float sigm(float v) { return 1.0f / (1.0f + __expf(-v)); }
__device__ __forceinline__ float gelu_tanh(float x) { const float u = 0.7978845608028654f * (x + 0.044715f * x * x * x); return x * sigm(2.0f * u); }
__device__ __forceinline__ bf16x8 pack8f(const float (&o)[8]) { u32x4 w; w.x = pk2(o[0], o[1]); w.y = pk2(o[2], o[3]); w.z = pk2(o[4], o[5]); w.w = pk2(o[6], o[7]); return __builtin_bit_cast(bf16x8, w); }
__device__ __forceinline__ void ph_conv(const Params& P, int layer) {
    const bf16* PROJ = (const bf16*)(P.ws + WS_PROJ); bf16* CONVB = (bf16*)(P.ws + WS_CONV);
    const int gid = blockIdx.x * NT + mk_tid();
    for (int it = gid; it < 128 * (MROWS / 16); it += gridDim.x * NT) {
        const int cg = it & 127, seg = it >> 7, m0 = seg * 16, t = m0 & (SEQ - 1);
        const bool lru = cg < 32;
        const int pcol = lru ? PB_X + 8 * cg : PC_XBC + 8 * (cg - 32);
        const float* cw = lru ? P.in[I_LCW] + layer * 4 * 256 + 8 * cg : P.in[I_SCW] + layer * 4 * 768 + 8 * (cg - 32);
        const float* cb = lru ? P.in[I_LCB] + layer * 256 + 8 * cg : P.in[I_SCB] + layer * 768 + 8 * (cg - 32);
        const int wst = lru ? 256 : 768;
        const f32x4 b0 = *(const f32x4*)cb, b1 = *(const f32x4*)(cb + 4);
        const f32x4 w00 = *(const f32x4*)cw, w01 = *(const f32x4*)(cw + 4), w10 = *(const f32x4*)(cw + wst), w11 = *(const f32x4*)(cw + wst + 4);
        const f32x4 w20 = *(const f32x4*)(cw + 2 * wst), w21 = *(const f32x4*)(cw + 2 * wst + 4), w30 = *(const f32x4*)(cw + 3 * wst), w31 = *(const f32x4*)(cw + 3 * wst + 4);
        const unsigned xo = (unsigned)m0 * NPROJ + pcol;
        const bf16x8 z8 = {0, 0, 0, 0, 0, 0, 0, 0};
        bf16x8 x1 = t >= 1 ? *(const bf16x8*)(PROJ + (xo - NPROJ)) : z8, x2 = t >= 2 ? *(const bf16x8*)(PROJ + (xo - 2 * NPROJ)) : z8, x3 = t >= 3 ? *(const bf16x8*)(PROJ + (xo - 3 * NPROJ)) : z8;
#pragma unroll 4
        for (int i = 0; i < 16; ++i) { const bf16x8 x0 = *(const bf16x8*)(PROJ + (xo + (unsigned)i * NPROJ)); float o[8];
#pragma unroll
            for (int e = 0; e < 4; ++e) {
                o[e] = b0[e] + w00[e] * bf2f((bf16)x3[e]) + w10[e] * bf2f((bf16)x2[e]) + w20[e] * bf2f((bf16)x1[e]) + w30[e] * bf2f((bf16)x0[e]);
                o[4 + e] = b1[e] + w01[e] * bf2f((bf16)x3[4 + e]) + w11[e] * bf2f((bf16)x2[4 + e]) + w21[e] * bf2f((bf16)x1[4 + e]) + w31[e] * bf2f((bf16)x0[4 + e]); }
            if (!lru) {
#pragma unroll
                for (int e = 0; e < 8; ++e) o[e] = o[e] * sigm(o[e]); }
            *(bf16x8*)(CONVB + ((unsigned)(m0 + i) * DM + 8 * cg)) = pack8f(o);
            x3 = x2; x2 = x1; x1 = x0; }
    }
}
template <int pass> __device__ __forceinline__ void ph_lru(const Params& P, int layer) {
    const int tid = mk_tid(), lane = tid & 63, wid = tid >> 6, r32 = lane & 31, hi = lane >> 5;
    const bf16* PROJ = (const bf16*)(P.ws + WS_PROJ); bf16* MIX = (bf16*)(P.ws + WS_MIX);
    float* LSUM = (float*)(P.ws + WS_LSUM); const float* LCAR = (const float*)(P.ws + WS_LSUM + 524288);
    const bf16* CONVB = (const bf16*)(P.ws + WS_CONV);
    const bf16* WT = (const bf16*)(P.ws + WS_TBL + TB_LRUW) + (size_t)layer * 2 * 4 * 64 * 64;
    const int hb = wid >> 1, nt = wid & 1, ch = hb * 64 + 32 * nt + r32;
    bf16x8 wa[4], wx[4];
#pragma unroll
    for (int ks = 0; ks < 4; ++ks) { wa[ks] = *(const bf16x8*)(WT + ((size_t)(hb * 64 + 32 * nt + r32)) * 64 + 16 * ks + 8 * hi);
        wx[ks] = *(const bf16x8*)(WT + ((size_t)((4 + hb) * 64 + 32 * nt + r32)) * 64 + 16 * ks + 8 * hi); }
    bf16x8 idf[2];
#pragma unroll
    for (int kk = 0; kk < 2; ++kk)
#pragma unroll
        for (int e = 0; e < 8; ++e) idf[kk][e] = (r32 == 16 * kk + 8 * hi + e) ? (short)0x3F80 : (short)0;
    const float sp = log1pf(expf(-P.in[I_LLAM][layer * 256 + ch])), bav = P.in[I_LBA][layer * 256 + ch], bxv = P.in[I_LBX][layer * 256 + ch];
    for (int item = blockIdx.x; item < 256; item += gridDim.x) {
        const int b = item >> 6, c = item & 63;
        float hst = 0.f, aprod = 1.f;
        if (pass == 1) hst = LCAR[(unsigned)((b * 64 + c) * 256 + ch)];
#pragma unroll 1
        for (int sc = 0; sc < 4; ++sc) {
            const int tl0 = c * 128 + sc * 32, t = tl0 + r32;
            bf16x8 af[4];
            const unsigned xo = (unsigned)(b * SEQ + t) * DM + hb * 64 + 8 * hi;
#pragma unroll
            for (int ks = 0; ks < 4; ++ks) af[ks] = *(const bf16x8*)(CONVB + (xo + 16 * ks));
            f32x16 accr = {}, acci = {}, accx = {};
#pragma unroll
            for (int ks = 0; ks < 4; ++ks) { accr = mfma32(af[ks], wa[ks], accr); acci = mfma32(af[ks], wx[ks], acci); }
            { const bf16x8 a0 = nt ? af[2] : af[0], a1 = nt ? af[3] : af[1]; accx = mfma32(a0, idf[0], accx); accx = mfma32(a1, idf[1], accx); }
            float av[16], bv[16];
#pragma unroll
            for (int r = 0; r < 16; ++r) { const float rg = sigm(accr[r] + bav), ig = sigm(acci[r] + bxv); const float la = -8.0f * rg * sp; const float a = __expf(la);
                av[r] = a; bv[r] = sqrtf(fmaxf(1.0f - a * a, 0.f)) * (ig * accx[r]); }
            float Ag[4], Hg[4], Ao[4], Ho[4], cin[4];
#pragma unroll
            for (int gi = 0; gi < 4; ++gi) { float A = 1.f, H = 0.f;
#pragma unroll
                for (int e = 0; e < 4; ++e) { H = av[4 * gi + e] * H + bv[4 * gi + e]; A *= av[4 * gi + e]; }
                Ag[gi] = A; Hg[gi] = H; Ao[gi] = __shfl_xor(A, 32); Ho[gi] = __shfl_xor(H, 32); }
            float carry = hst;
#pragma unroll
            for (int gi = 0; gi < 4; ++gi) { const float A0 = hi ? Ao[gi] : Ag[gi], H0 = hi ? Ho[gi] : Hg[gi], A1 = hi ? Ag[gi] : Ao[gi], H1 = hi ? Hg[gi] : Ho[gi];
                const float c0 = carry; carry = A0 * carry + H0; const float c1 = carry; carry = A1 * carry + H1; cin[gi] = hi ? c1 : c0; aprod *= A0 * A1; }
            hst = carry;
            if (pass == 1) {
                const unsigned rowq = (unsigned)(b * SEQ + tl0 + 4 * hi);
#pragma unroll
                for (int gi = 0; gi < 4; ++gi) { float h = cin[gi];
                    asm volatile("" ::: "memory");
#pragma unroll
                    for (int e = 0; e < 4; ++e) { const int r = 4 * gi + e; h = av[r] * h + bv[r]; const unsigned row = rowq + 8 * gi + e;
                        const float g = bf2f(PROJ[row * NPROJ + PB_G + ch]); MIX[row * DM + MX_B + ch] = (bf16)f2bf(gelu_tanh(g) * h); } }
            }
        }
        if (pass == 0 && hi == 0) { LSUM[(unsigned)((b * 64 + c) * 512 + ch)] = aprod; LSUM[(unsigned)((b * 64 + c) * 512 + 256 + ch)] = hst; }
    }
}

__device__ __forceinline__ float softplusf(float v) { return v > 20.f ? v : log1pf(expf(v)); }
__device__ __forceinline__ bf16x8 trfrag(const unsigned char* tile, int ks, int ct, int lane) {
    const unsigned char* p = tile + (16 * ks + 4 * (lane >> 5) + ((lane & 15) >> 2)) * 272 + (32 * ct + 16 * ((lane >> 4) & 1) + 4 * (lane & 3)) * 2;
    const s16x4 lo = vtr(p), hi = vtr(p + 8 * 272);
    return (bf16x8){lo[0], lo[1], lo[2], lo[3], hi[0], hi[1], hi[2], hi[3]};
}
template <int pass> __device__ __forceinline__ void ph_ssd(const Params& P, int layer, unsigned char* lds) {
    const int tid = mk_tid(), lane = tid & 63, wid = tid >> 6, r32 = lane & 31, hi = lane >> 5;
    unsigned char* R0 = lds; unsigned char* R1 = lds + 34816; unsigned char* R2 = lds + 2 * 34816; unsigned char* R3 = lds + 3 * 34816;
    float* dtv = (float*)(lds + 4 * 34816); float* acum = dtv + 256; float* wsc = acum + 256; float* tot = wsc + 256; float* rstd = tot + 8;
    float* YB = (float*)lds;
    const bf16* PROJ = (const bf16*)(P.ws + WS_PROJ); bf16* MIX = (bf16*)(P.ws + WS_MIX);
    const float* DT = (const float*)(P.ws + WS_DT); float* ST = (float*)(P.ws + WS_ST); float* CD = (float*)(P.ws + WS_CDEC);
    const bf16* CONVB = (const bf16*)(P.ws + WS_CONV);
    for (int item = blockIdx.x; item < 512; item += gridDim.x) {
        const int g = item & 1, c = (item >> 1) & 63, b = item >> 7, t0 = c * 128; const unsigned rowb = (unsigned)b * SEQ;
        int tv = tid; asm volatile("" : "+v"(tv));
        __syncthreads();
        if (tid < 256) { const int s = tid & 127, hl = tid >> 7, hh = 2 * g + hl;
            const float dt = softplusf(DT[(rowb + t0 + s) * 4 + hh] + P.in[I_SDTB][layer * 4 + hh]); float v = dt * -expf(P.in[I_SALOG][layer * 4 + hh]);
#pragma unroll
            for (int o = 1; o < 64; o <<= 1) { const float u = __shfl_up(v, o); if (lane >= o) v += u; }
            dtv[tid] = dt; acum[tid] = v; if (lane == 63) tot[wid] = v; }
        __syncthreads();
        if (tid < 256 && (tid & 64)) acum[tid] += tot[wid - 1];
        __syncthreads();
        if (pass == 0) { if (tid < 256) wsc[tid] = dtv[tid] * __expf(acum[(tid & 128) + 127] - acum[tid]); __syncthreads(); }
        { constexpr int NCH = pass == 0 ? 8 : 12;
#pragma unroll
          for (int i = 0; i < NCH; ++i) { const int idx = tv + NT * i, tile = idx >> 11, row = (idx >> 4) & 127, c16 = idx & 15;
              bf16x8 v = *(const bf16x8*)(CONVB + ((rowb + t0 + row) * DM + 256 + 256 * tile + g * 128 + 8 * c16));
              if (pass == 0 && tile == 0) { const float sc = wsc[(c16 >> 3) * 128 + row]; float o[8];
#pragma unroll
                  for (int e = 0; e < 8; ++e) o[e] = bf2f((bf16)v[e]) * sc;
                  v = pack8f(o); }
              unsigned char* dst = (tile == 0 ? (pass == 0 ? R0 : R2) : (tile == 1 ? R1 : R0));
              *(bf16x8*)(dst + row * 272 + c16 * 16) = v; } }
        const int mt = wid >> 1, nt0 = 2 * (wid & 1);
        if (pass == 0) {
            __syncthreads();
            f32x16 acc[2]; acc[0] = f32x16{}; acc[1] = f32x16{};
#pragma unroll
            for (int ks = 0; ks < 8; ++ks) { const bf16x8 a = trfrag(R0, ks, mt, lane); acc[0] = mfma32(a, trfrag(R1, ks, nt0, lane), acc[0]); acc[1] = mfma32(a, trfrag(R1, ks, nt0 + 1, lane), acc[1]); }
#pragma unroll
            for (int j = 0; j < 2; ++j)
#pragma unroll
                for (int r = 0; r < 16; ++r) { const int pl = 32 * mt + crow(r, hi), hh = 2 * g + (pl >> 6); ST[(unsigned)(((b * 64 + c) * 4 + hh) * 8192 + (pl & 63) * 128 + 32 * (nt0 + j) + r32)] = acc[j][r]; }
            if (tid < 2) CD[(b * 64 + c) * 4 + 2 * g + tid] = __expf(acum[tid * 128 + 127]);
        } else {
#pragma unroll
            for (int i = 0; i < 8; ++i) { const int idx = tv + NT * i, pl = idx >> 5, n4 = (idx & 31) * 4;
                const f32x4 v = *(const f32x4*)(ST + (unsigned)(((b * 64 + c) * 4 + 2 * g + (pl >> 6)) * 8192 + (pl & 63) * 128 + n4));
                u32x2 w; w.x = pk2(v.x, v.y); w.y = pk2(v.z, v.w); *(u32x2*)(R3 + pl * 272 + n4 * 2) = w; }
            __syncthreads();
            f32x16 cbt[2], ya[2]; cbt[0] = f32x16{}; cbt[1] = f32x16{}; ya[0] = f32x16{}; ya[1] = f32x16{};
#pragma unroll 2
            for (int ks = 0; ks < 8; ++ks) { const int ko = (16 * ks + 8 * hi) * 2; const bf16x8 a = *(const bf16x8*)(R0 + (32 * mt + r32) * 272 + ko);
                cbt[0] = mfma32(a, *(const bf16x8*)(R1 + (32 * nt0 + r32) * 272 + ko), cbt[0]);
                cbt[1] = mfma32(a, *(const bf16x8*)(R1 + (32 * (nt0 + 1) + r32) * 272 + ko), cbt[1]);
                ya[0] = mfma32(a, *(const bf16x8*)(R3 + (32 * (wid & 1) + r32) * 272 + ko), ya[0]);
                ya[1] = mfma32(a, *(const bf16x8*)(R3 + (64 + 32 * (wid & 1) + r32) * 272 + ko), ya[1]); }
#pragma unroll
            for (int hl = 0; hl < 2; ++hl)
#pragma unroll
                for (int r = 0; r < 16; ++r) ya[hl][r] *= __expf(acum[hl * 128 + 32 * mt + crow(r, hi)]);
            __syncthreads();
#pragma unroll
            for (int hl = 0; hl < 2; ++hl) { unsigned char* dstm = hl ? R0 : R1;
#pragma unroll
                for (int j = 0; j < 2; ++j) { const int s = 32 * (nt0 + j) + r32; const float as = acum[hl * 128 + s], ds = dtv[hl * 128 + s];
#pragma unroll
                    for (int r = 0; r < 16; ++r) { const int lrow = 32 * mt + crow(r, hi);
                        const float v = (s <= lrow) ? cbt[j][r] * __expf(fminf(acum[hl * 128 + lrow] - as, 0.f)) * ds : 0.f; *(bf16*)(dstm + lrow * 272 + s * 2) = (bf16)f2bf(v); } } }
            __syncthreads();
#pragma unroll
            for (int hl = 0; hl < 2; ++hl) { const unsigned char* Mh = (hl ? R0 : R1) + (32 * mt + r32) * 272 + 8 * hi; const int pt = 2 * hl + (wid & 1);
#pragma unroll 2
                for (int ks = 0; ks < 8; ++ks) { const s16x4 lo = *(const s16x4*)(Mh + 32 * ks), h4 = *(const s16x4*)(Mh + 32 * ks + 16);
                    ya[hl] = mfma32((bf16x8){lo[0], lo[1], lo[2], lo[3], h4[0], h4[1], h4[2], h4[3]}, trfrag(R2, ks, pt, lane), ya[hl]); } }
#pragma unroll
            for (int hl = 0; hl < 2; ++hl) { const int hh = 2 * g + hl, pl = 64 * hl + 32 * (wid & 1) + r32; const float dsk = P.in[I_SD][layer * 4 + hh];
#pragma unroll
                for (int r = 0; r < 16; ++r) { const int lrow = 32 * mt + crow(r, hi); const float xv = bf2f(*(const bf16*)(R2 + lrow * 272 + pl * 2));
                    const float z = bf2f(PROJ[(rowb + t0 + lrow) * NPROJ + PC_Z + hh * 64 + (pl & 63)]); ya[hl][r] = (ya[hl][r] + dsk * xv) * (z * sigm(z)); } }
            __syncthreads();
#pragma unroll
            for (int hl = 0; hl < 2; ++hl) { const int pl = 64 * hl + 32 * (wid & 1) + r32;
#pragma unroll
                for (int r = 0; r < 16; ++r) YB[(32 * mt + crow(r, hi)) * 132 + pl] = ya[hl][r]; }
            __syncthreads();
            { const int lrow = tv >> 2, q = tv & 3; const float* yr = YB + lrow * 132 + q; float ss = 0.f;
#pragma unroll
              for (int e = 0; e < 32; ++e) ss += yr[4 * e] * yr[4 * e];
              ss += __shfl_xor(ss, 1); ss += __shfl_xor(ss, 2);
              if (q == 0) rstd[lrow] = 1.0f / sqrtf(ss * (1.0f / 128.0f) + EPS); }
            __syncthreads();
#pragma unroll
            for (int i = 0; i < 4; ++i) { const int idx = tv + NT * i, lrow = idx >> 4, cn = idx & 15; const float rs = rstd[lrow];
                const f32x4 y0 = *(const f32x4*)(YB + lrow * 132 + 8 * cn), y1 = *(const f32x4*)(YB + lrow * 132 + 8 * cn + 4);
                const float* gn = P.in[I_SNORM] + layer * 256 + g * 128 + 8 * cn; const f32x4 g0 = *(const f32x4*)gn, g1 = *(const f32x4*)(gn + 4);
                u32x4 w; w.x = pk2(y0.x * rs * g0.x, y0.y * rs * g0.y); w.y = pk2(y0.z * rs * g0.z, y0.w * rs * g0.w); w.z = pk2(y1.x * rs * g1.x, y1.y * rs * g1.y); w.w = pk2(y1.z * rs * g1.z, y1.w * rs * g1.w);
                *(u32x4*)(MIX + (rowb + t0 + lrow) * DM + MX_C + g * 128 + 8 * cn) = w; }
        }
    }
}
__device__ __forceinline__ void ph_scan(const Params& P) {
    float* ST = (float*)(P.ws + WS_ST); const float* CD = (const float*)(P.ws + WS_CDEC);
    const int gid = blockIdx.x * NT + mk_tid();
    for (int e = gid; e < BATCH * 4 * 8192; e += gridDim.x * NT) {
        const int b = e >> 15, hh = (e >> 13) & 3, pn = e & 8191; float carry = 0.f;
#pragma unroll 1
        for (int c0 = 0; c0 < 64; c0 += 8) { float st[8], cd[8];
#pragma unroll
            for (int i = 0; i < 8; ++i) { st[i] = ST[((size_t)((b * 64 + c0 + i) * 4 + hh)) * 8192 + pn]; cd[i] = CD[(b * 64 + c0 + i) * 4 + hh]; }
#pragma unroll
            for (int i = 0; i < 8; ++i) { ST[((size_t)((b * 64 + c0 + i) * 4 + hh)) * 8192 + pn] = carry; carry = carry * cd[i] + st[i]; } }
    }
    const float* LSUM = (const float*)(P.ws + WS_LSUM); float* LCAR = (float*)(P.ws + WS_LSUM + 524288);
    if (gid < BATCH * 256) { const int b = gid >> 8, ch = gid & 255; float carry = 0.f;
#pragma unroll 1
        for (int c0 = 0; c0 < 64; c0 += 8) { float a[8], h[8];
#pragma unroll
            for (int i = 0; i < 8; ++i) { a[i] = LSUM[(size_t)(b * 64 + c0 + i) * 512 + ch]; h[i] = LSUM[(size_t)(b * 64 + c0 + i) * 512 + 256 + ch]; }
#pragma unroll
            for (int i = 0; i < 8; ++i) { LCAR[(size_t)(b * 64 + c0 + i) * 256 + ch] = carry; carry = a[i] * carry + h[i]; } }
    }
}

constexpr int NPH = 1 + 10 * DEPTH;
#ifndef MK_REP_DIFF
#define MK_REP_DIFF 1
#endif
#ifndef MK_REP_DIL
#define MK_REP_DIL 1
#endif
#ifndef MK_REP_BC1
#define MK_REP_BC1 1
#endif
#ifndef MK_REP_BC0
#define MK_REP_BC0 1
#endif
__global__ void __launch_bounds__(NT, 2) mega(Params P, int ph_lo, int ph_hi) {
    extern __shared__ __attribute__((aligned(16))) unsigned char lds[];
    cooperative_groups::grid_group grid = cooperative_groups::this_grid();
    unsigned char* ws = P.ws;
    bf16* XN = (bf16*)(ws + WS_XN); bf16* PROJ = (bf16*)(ws + WS_PROJ); bf16* MIX = (bf16*)(ws + WS_MIX); bf16* HID = (bf16*)(ws + WS_HID);
    float* Y1 = (float*)(ws + WS_Y1); float* Y2 = (float*)(ws + WS_Y2); float* DT = (float*)(ws + WS_DT);
#define MK_PH(k) (ph_lo <= (k) && (k) < ph_hi)
#define MK_SEAM(k) do { if ((k) + 1 < ph_hi) grid.sync(); } while (0)
    if (MK_PH(0)) {
        ph_prep(P, lds);
        ph_row(nullptr, nullptr, P.in[I_X], nullptr, P.in[I_NMPRE], XN, P.in[I_WIN] + 2304, DT);
        MK_SEAM(0);
    }
#pragma unroll 1
    for (int layer = 0; layer < DEPTH; ++layer) {
        const int pb = 1 + 10 * layer;
        const bf16* wl = (const bf16*)(ws + WS_W + (size_t)layer * W_LAYER);
        const float* hin = layer == 0 ? P.in[I_X] : P.out;
        if (MK_PH(pb + 0)) { pg8::Gemm g{XN, wl + WO_IN / 2, MROWS, NPROJ, DM, 0}; pg8::EpiBf16R<0> e{PROJ, NPROJ, 0}; ph_gemm(g, e, lds); MK_SEAM(pb + 0); }
        if (MK_PH(pb + 1)) {
            ph_conv(P, layer);
#pragma unroll 1
            for (int rep = 0; rep < MK_REP_DIL; ++rep) { ph_dilated(P, lds); __syncthreads(); }
            MK_SEAM(pb + 1); }
        if (MK_PH(pb + 2)) {
#pragma unroll 1
            for (int rep = 0; rep < MK_REP_BC0; ++rep) { ph_lru<0>(P, layer); __syncthreads(); ph_ssd<0>(P, layer, lds); __syncthreads(); }
            MK_SEAM(pb + 2); }
        if (MK_PH(pb + 3)) { ph_scan(P); MK_SEAM(pb + 3); }
        if (MK_PH(pb + 4)) {
#pragma unroll 1
            for (int rep = 0; rep < MK_REP_DIFF; ++rep) { ph_diff(P, layer, lds); __syncthreads(); }
#pragma unroll 1
            for (int rep = 0; rep < MK_REP_BC1; ++rep) { ph_lru<1>(P, layer); __syncthreads(); ph_ssd<1>(P, layer, lds); __syncthreads(); }
            MK_SEAM(pb + 4); }
        if (MK_PH(pb + 5)) { pg8::Gemm g{MIX, wl + WO_OUT / 2, MROWS, DM, DM, 0}; pg8::EpiF32 e{Y1, DM, 0}; ph_gemm(g, e, lds); MK_SEAM(pb + 5); }
        if (MK_PH(pb + 6)) { ph_row(Y1, P.in[I_NMPOST] + layer * DM, hin, P.out, P.in[I_NFPRE] + layer * DM, XN, nullptr, nullptr); MK_SEAM(pb + 6); }
        if (MK_PH(pb + 7)) { pg8::Gemm g{XN, wl + WO_UP / 2, MROWS, DFF, DM, 0}; pg8::EpiBf16R<2> e{HID, DFF, 0}; ph_gemm(g, e, lds); MK_SEAM(pb + 7); }
        if (MK_PH(pb + 8)) { pg8::Gemm g{HID, wl + WO_DOWN / 2, MROWS, DM, DFF, 0}; pg8::EpiF32 e{Y2, DM, 0}; ph_gemm(g, e, lds); MK_SEAM(pb + 8); }
        if (MK_PH(pb + 9)) { const bool last = layer == DEPTH - 1;
            ph_row(Y2, P.in[I_NFPOST] + layer * DM, P.out, P.out, last ? nullptr : P.in[I_NMPRE] + (layer + 1) * DM, XN, last ? nullptr : P.in[I_WIN] + (size_t)(layer + 1) * DM * PIN + 2304, DT);
            MK_SEAM(pb + 9); }
    }
}
}

#ifndef MK_N_LAUNCHES
#define MK_N_LAUNCHES 1
#endif
extern "C" void kernel_launch(void* const* d_in, const int* in_sizes, int n_in, void* d_out, int out_size, void* d_ws, size_t ws_size, hipStream_t stream) {
    using namespace mk;
    static int grid = 0;
    if (grid == 0) {
        if (n_in != N_IN || in_sizes[0] != MROWS * DM || out_size != MROWS * DM || ws_size < WS_END) {
            fprintf(stderr, "kernel_launch: unexpected shapes: n_in %d in0 %d out %d ws %zu (need %zu)\n", n_in, n_in > 0 ? in_sizes[0] : -1, out_size, ws_size, (size_t)WS_END); grid = -1; return; }
        (void)hipFuncSetAttribute((const void*)mega, hipFuncAttributeMaxDynamicSharedMemorySize, LDS_BYTES);
        int dev = 0, cus = 0, per_cu = 0;
        (void)hipGetDevice(&dev);
        (void)hipDeviceGetAttribute(&cus, hipDeviceAttributeMultiprocessorCount, dev);
        (void)hipOccupancyMaxActiveBlocksPerMultiprocessor(&per_cu, (const void*)mega, NT, LDS_BYTES);
        (void)hipGetLastError();
        if (per_cu < 1 || cus < 1) { fprintf(stderr, "kernel_launch: occupancy query: %d blocks/CU, %d CUs\n", per_cu, cus); grid = -1; return; }
        grid = cus;
    }
    if (grid < 0) return;
    Params P{};
    for (int i = 0; i < N_IN; ++i) P.in[i] = (const float*)d_in[i];
    P.out = (float*)d_out; P.ws = (unsigned char*)d_ws;
#if MK_N_LAUNCHES == 1
    int lo = 0, hi = NPH;
    void* args[] = {(void*)&P, (void*)&lo, (void*)&hi};
    hipError_t e = hipLaunchCooperativeKernel((const void*)mega, dim3(grid), dim3(NT), args, LDS_BYTES, stream);
    if (e != hipSuccess) fprintf(stderr, "kernel_launch: cooperative launch failed: %s (grid %d)\n", hipGetErrorString(e), grid);
#else
    for (int p = 0; p < NPH; ++p) hipLaunchKernelGGL(mega, dim3(grid), dim3(NT), LDS_BYTES, stream, P, p, p + 1);
#endif
}
```

```cpp
#include <hip/hip_runtime.h>
#include <cstdio>
#include <cstdint>
#include <cmath>
#include <hip/hip_cooperative_groups.h>
__device__ __forceinline__ int mk_tid() { int t = (int)threadIdx.x; asm volatile("" : "+v"(t)); return t; }
namespace pg8 {
#define PG8_LAS __attribute__((address_space(3)))
typedef unsigned short bf16_t;
typedef short bf16x8 __attribute__((ext_vector_type(8)));
typedef float f32x4 __attribute__((ext_vector_type(4)));
typedef unsigned u32x4 __attribute__((ext_vector_type(4)));
constexpr int BM = 256, BK = 64, HALF = 128, HTB = HALF * BK * 2  , STAGE_BYTES = 8 * HTB, NXCD = 8, WGM = 8;

__host__ __device__ __forceinline__ int lds_byte(int r, int c) { const int st = (r >> 4) * 2 + (c >> 5), rr = r & 15, cc = c & 31, ob = rr * 64 + cc * 2; return st * 1024 + (ob ^ (((ob >> 9) & 1) << 5)); }
__host__ __device__ __forceinline__ void stage_rc(int b, int& R, int& C) { const int st = b / 1024, sb = b % 1024, swz = sb ^ (((sb >> 9) & 1) << 5); R = (st >> 1) * 16 + swz / 64; C = (st & 1) * 32 + (swz % 64) / 2; }
__host__ __device__ __forceinline__ int perm32(int rho) { const int n = rho >> 4, i = rho & 15; return 8 * (i >> 2) + 4 * n + (i & 3); }

struct Unit { int pm, pn; };
struct Gemm { const bf16_t* A; const bf16_t* Bt; int M, N, K, pad; };

struct StaticOrder {
    int nM, nN, nwg, G, c;
    __host__ __device__ void init(int M, int N, int G_, int c_) { nM = M / BM; nN = N / BM; nwg = nM * nN; G = G_; c = c_; }
    __host__ __device__ bool next(int i, Unit& u) const {
        const long L = (long)i * G + c; if (L >= nwg) return false;
        int wgid = (int)L; { const int q = nwg / NXCD, r = nwg % NXCD, xcd = wgid % NXCD, off = wgid / NXCD; wgid = (xcd < r ? xcd * (q + 1) : r * (q + 1) + (xcd - r) * q) + off; }
        const int nig = WGM * nN, gid = wgid / nig, fm = gid * WGM, gsz = (nM - fm) < WGM ? (nM - fm) : WGM;
        u.pm = fm + ((wgid % nig) % gsz); u.pn = (wgid % nig) / gsz; return true;
    }
    __device__ __forceinline__ void a_ready(const Unit&) const {}
    __device__ __forceinline__ void done(const Unit&) const {}
};

__device__ __forceinline__ unsigned cvt_pk_bf16(float lo, float hi) { unsigned r; asm volatile("v_cvt_pk_bf16_f32 %0, %1, %2" : "=v"(r) : "v"(lo), "v"(hi)); return r; }
typedef float f32x2 __attribute__((ext_vector_type(2)));
__device__ __forceinline__ f32x2 gelu_pk(f32x2 v) {
    const f32x2 av = __builtin_elementwise_abs(v), d = av * 0.2316418882f + 1.0f;
    f32x2 t; t.x = __builtin_amdgcn_rcpf(d.x); t.y = __builtin_amdgcn_rcpf(d.y);
    f32x2 q = t * 0.5307027145f + (-0.7265760135f); q = q * t + 0.7107068705f; q = q * t + (-0.142248368f); q = q * t + 0.127414796f; q = q * t;
    const f32x2 s = (v * v) * (-0.72134752044f);
    f32x2 e; e.x = __builtin_amdgcn_exp2f(s.x); e.y = __builtin_amdgcn_exp2f(s.y);
    const f32x2 m = v * (q * e), r = v - m;
    f32x2 o; o.x = v.x < 0.f ? m.x : r.x; o.y = v.y < 0.f ? m.y : r.y; return o;
}

template <int ACT  > struct EpiBf16 {
    static constexpr bool PERM = true, AFTER_DRAIN = false; static_assert(ACT == 0 || ACT == 1, "EpiBf16: ACT is 0 (none) or 1 (gelu_pk)");
    bf16_t* O; int ldc; const float* bias; int split_cols; size_t split_stride; float scale0;
    __device__ __forceinline__ void operator()(const f32x4 (&acc)[2][2][4][2], const Unit& u, int wr, int wc, int fr, int fq) const {
        const int row0 = u.pm * BM + wr * 64 + fr; int colt = u.pn * BM; bf16_t* base = O;
        float sc = 1.f; if (split_cols) { const int t = colt / split_cols; base += (size_t)t * split_stride; colt -= t * split_cols; if (t == 0) sc = scale0; }
        const int col0 = colt + wc * 32 + 8 * fq, bcol0 = u.pn * BM + wc * 32 + 8 * fq;
        f32x4 bv[2][2];
#pragma unroll
        for (int bj = 0; bj < 2; ++bj)
#pragma unroll
            for (int n = 0; n < 2; ++n) bv[bj][n] = bias ? *(const f32x4*)(bias + bcol0 + bj * HALF + 4 * n) : (f32x4){0.f, 0.f, 0.f, 0.f};
#pragma unroll
        for (int ai = 0; ai < 2; ++ai)
#pragma unroll
            for (int m = 0; m < 4; ++m) { bf16_t* rowp = base + (size_t)(row0 + ai * HALF + m * 16) * ldc + col0;
#pragma unroll
                for (int bj = 0; bj < 2; ++bj) { f32x4 v0 = acc[ai][bj][m][0] + bv[bj][0], v1 = acc[ai][bj][m][1] + bv[bj][1];
                    if (ACT == 1) { f32x2 a = gelu_pk((f32x2){v0[0], v0[1]}), b = gelu_pk((f32x2){v0[2], v0[3]}), c = gelu_pk((f32x2){v1[0], v1[1]}), d = gelu_pk((f32x2){v1[2], v1[3]});
                        v0 = (f32x4){a.x, a.y, b.x, b.y}; v1 = (f32x4){c.x, c.y, d.x, d.y}; }
                    v0 = v0 * sc; v1 = v1 * sc; u32x4 w; w.x = cvt_pk_bf16(v0[0], v0[1]); w.y = cvt_pk_bf16(v0[2], v0[3]); w.z = cvt_pk_bf16(v1[0], v1[1]); w.w = cvt_pk_bf16(v1[2], v1[3]);
                    *(u32x4*)(rowp + bj * HALF) = w; } }
    }
};

struct PanelStats {
    unsigned* xbuf;
    unsigned* cnt;
    unsigned* tmo;
    int ntn; float eps;
    unsigned code;
    __device__ __forceinline__ bool run(const f32x4 (&v)[2][2][4][2], const Unit& u, int wr, int wc, int fr, int fq, PG8_LAS unsigned char* lds, int wid, int lane) const {
        typedef float f32x2v __attribute__((ext_vector_type(2)));
        PG8_LAS f32x2v* P = (PG8_LAS f32x2v*)lds;
        PG8_LAS f32x2v* S = (PG8_LAS f32x2v*)(lds + 8192);
        PG8_LAS unsigned* flag = (PG8_LAS unsigned*)(lds + 8192 + 2048);
#pragma unroll
        for (int ai = 0; ai < 2; ++ai)
#pragma unroll
            for (int m = 0; m < 4; ++m) {
                float s = 0.f;
#pragma unroll
                for (int bj = 0; bj < 2; ++bj)
#pragma unroll
                    for (int n = 0; n < 2; ++n) { const f32x4 x = v[ai][bj][m][n]; s += (x[0] + x[1]) + (x[2] + x[3]); }
                s += __shfl_xor(s, 16); s += __shfl_xor(s, 32);
                const float mw = s * (1.0f / 64.0f); float q = 0.f;
#pragma unroll
                for (int bj = 0; bj < 2; ++bj)
#pragma unroll
                    for (int n = 0; n < 2; ++n) { const f32x4 d = v[ai][bj][m][n] - mw; q += (d[0] * d[0] + d[1] * d[1]) + (d[2] * d[2] + d[3] * d[3]); }
                q += __shfl_xor(q, 16); q += __shfl_xor(q, 32);
                if (fq == 0) P[(ai * HALF + wr * 64 + m * 16 + fr) * 4 + wc] = (f32x2v){mw, q};
            }
        asm volatile("s_waitcnt lgkmcnt(0)" ::: "memory"); __builtin_amdgcn_s_barrier(); asm volatile("" ::: "memory");
#if defined(BROKEN_EXCHANGE_NO_WAIT)
#warning BROKEN CONTROL BUILD: the row-statistics exchange does not wait; results are wrong by design
        if (blockIdx.x >= 64) { const long long t0_ = clock64(); while (clock64() - t0_ < 60000) __builtin_amdgcn_s_sleep(8); }
#endif
        const int row = wid * 32 + (lane & 31);
        if (lane < 32) {
            const f32x2v a = P[row * 4 + 0], b = P[row * 4 + 1], c = P[row * 4 + 2], d = P[row * 4 + 3];
            const float mt = (a.x + b.x + c.x + d.x) * 0.25f;
            const float da = a.x - mt, db = b.x - mt, dc = c.x - mt, dd = d.x - mt;
            const float m2 = (a.y + b.y) + (c.y + d.y) + 64.0f * ((da * da + db * db) + (dc * dc + dd * dd));
            unsigned long long* slot = (unsigned long long*)xbuf + ((size_t)(u.pm * BM + row) * 4 + u.pn);
            __hip_atomic_store(slot, ((unsigned long long)__float_as_uint(m2) << 32) | __float_as_uint(mt), __ATOMIC_RELAXED, __HIP_MEMORY_SCOPE_AGENT);
        }
        asm volatile("s_waitcnt vmcnt(0)" ::: "memory");
        if (lane == 0) __hip_atomic_fetch_add(cnt + 64 * u.pm, 1u, __ATOMIC_RELAXED, __HIP_MEMORY_SCOPE_AGENT);
        if (wid == 0) {
            bool dead = false; const unsigned long long t0 = __builtin_amdgcn_s_memrealtime(); const unsigned want = 8u * (unsigned)ntn;
            for (;;) {
#if defined(BROKEN_EXCHANGE_NO_WAIT)
                break;
#endif
                if ((unsigned)__builtin_amdgcn_readfirstlane(__hip_atomic_load(cnt + 64 * u.pm, __ATOMIC_RELAXED, __HIP_MEMORY_SCOPE_AGENT)) >= want) break;
                if (__builtin_amdgcn_s_memrealtime() - t0 > 2000000ull) {
                    if (lane == 0) { unsigned expect = 0u; __hip_atomic_compare_exchange_strong(tmo + 1, &expect, code | (unsigned)(u.pm & 0xff), __ATOMIC_RELAXED, __ATOMIC_RELAXED, __HIP_MEMORY_SCOPE_AGENT);
                                     __hip_atomic_store(tmo, 1u, __ATOMIC_RELAXED, __HIP_MEMORY_SCOPE_AGENT); }
                    dead = true; break; }
                __builtin_amdgcn_s_sleep(2);
            }
            __builtin_amdgcn_fence(__ATOMIC_ACQUIRE, "agent");
            if (lane == 0) flag[0] = dead ? 1u : 0u;
        }
        asm volatile("s_waitcnt vmcnt(0) lgkmcnt(0)" ::: "memory"); __builtin_amdgcn_s_barrier(); asm volatile("" ::: "memory");
        const bool bad = flag[0] != 0u;
        if (lane < 32) {
            const unsigned long long* slot = (const unsigned long long*)xbuf + (size_t)(u.pm * BM + row) * 4; float mt[4], m2[4]; float ms = 0.f;
#pragma unroll
            for (int t = 0; t < 4; ++t) { if (t < ntn) { const unsigned long long w = __hip_atomic_load(slot + t, __ATOMIC_RELAXED, __HIP_MEMORY_SCOPE_AGENT); mt[t] = __uint_as_float((unsigned)w); m2[t] = __uint_as_float((unsigned)(w >> 32)); } else { mt[t] = 0.f; m2[t] = 0.f; } ms += mt[t]; }
            const float mean = ms / (float)ntn; float q = 0.f;
#pragma unroll
            for (int t = 0; t < 4; ++t) if (t < ntn) { const float dm = mt[t] - mean; q += m2[t] + 256.0f * dm * dm; }
            S[row] = (f32x2v){mean, 1.0f / sqrtf(q / (256.0f * (float)ntn) + eps)};
        }
        asm volatile("s_waitcnt lgkmcnt(0)" ::: "memory"); __builtin_amdgcn_s_barrier(); asm volatile("" ::: "memory");
        return bad;
    }
};
struct EpiLnRes {
    static constexpr bool PERM = false, AFTER_DRAIN = true;
    const float* base; float* out; int ldc; const float* bias; PanelStats st; unsigned poison;
    __device__ __forceinline__ void fused(f32x4 (&acc)[2][2][4][2], const Unit& u, int wr, int wc, int fr, int fq, PG8_LAS unsigned char* lds, int wid, int lane) const {
        typedef float f32x2v __attribute__((ext_vector_type(2)));
        const PG8_LAS f32x2v* S = (const PG8_LAS f32x2v*)(lds + 8192);
        const int col0 = u.pn * BM + wc * 32 + 4 * fq;
#pragma unroll
        for (int bj = 0; bj < 2; ++bj)
#pragma unroll
            for (int n = 0; n < 2; ++n) { const f32x4 bv = bias ? *(const f32x4*)(bias + col0 + bj * HALF + n * 16) : (f32x4){0.f, 0.f, 0.f, 0.f};
#pragma unroll
                for (int ai = 0; ai < 2; ++ai)
#pragma unroll
                    for (int m = 0; m < 4; ++m) acc[ai][bj][m][n] += bv; }
        f32x4 pre[4][2][2];
#pragma unroll
        for (int m = 0; m < 4; ++m) { const size_t off = (size_t)(u.pm * BM + wr * 64 + m * 16 + fr) * ldc + col0;
#pragma unroll
            for (int bj = 0; bj < 2; ++bj)
#pragma unroll
                for (int n = 0; n < 2; ++n) pre[m][bj][n] = *(const f32x4*)(base + off + bj * HALF + n * 16); }
        const bool bad = st.run(acc, u, wr, wc, fr, fq, lds, wid, lane) || poison != 0u;
        const float qnan = __builtin_nanf("");
#pragma unroll
        for (int ai = 0; ai < 2; ++ai)
#pragma unroll
            for (int m = 0; m < 4; ++m) { const int r = ai * HALF + wr * 64 + m * 16 + fr; const f32x2v sr = S[r]; const size_t off = (size_t)(u.pm * BM + r) * ldc + col0;
#pragma unroll
                for (int bj = 0; bj < 2; ++bj)
#pragma unroll
                    for (int n = 0; n < 2; ++n) { const f32x4 bs = ai == 0 ? pre[m][bj][n] : *(const f32x4*)(base + off + bj * HALF + n * 16); f32x4 o = bs + (acc[ai][bj][m][n] - sr.x) * sr.y;
                        if (bad) o = (f32x4){qnan, qnan, qnan, qnan}; *(f32x4*)(out + off + bj * HALF + n * 16) = o; }
                if (m & 1) asm volatile("" ::: "memory"); }
    }
};
struct EpiLnResLn {
    static constexpr bool PERM = false, AFTER_DRAIN = true;
    const float* base; float* out; bf16_t* xn; int ldc; const float* bias; PanelStats st1, st2; unsigned poison;
    __device__ __forceinline__ void fused(f32x4 (&acc)[2][2][4][2], const Unit& u, int wr, int wc, int fr, int fq, PG8_LAS unsigned char* lds, int wid, int lane) const {
        typedef float f32x2v __attribute__((ext_vector_type(2))); typedef unsigned u32x2v __attribute__((ext_vector_type(2)));
        const PG8_LAS f32x2v* S = (const PG8_LAS f32x2v*)(lds + 8192);
        const int col0 = u.pn * BM + wc * 32 + 4 * fq;
#pragma unroll
        for (int bj = 0; bj < 2; ++bj)
#pragma unroll
            for (int n = 0; n < 2; ++n) { const f32x4 bv = bias ? *(const f32x4*)(bias + col0 + bj * HALF + n * 16) : (f32x4){0.f, 0.f, 0.f, 0.f};
#pragma unroll
                for (int ai = 0; ai < 2; ++ai)
#pragma unroll
                    for (int m = 0; m < 4; ++m) acc[ai][bj][m][n] += bv; }
        bool bad = st1.run(acc, u, wr, wc, fr, fq, lds, wid, lane) || poison != 0u;
        const float qnan = __builtin_nanf("");
#pragma unroll
        for (int ai = 0; ai < 2; ++ai)
#pragma unroll
            for (int m = 0; m < 4; ++m) { const int r = ai * HALF + wr * 64 + m * 16 + fr; const f32x2v sr = S[r]; const size_t off = (size_t)(u.pm * BM + r) * ldc + col0;
#pragma unroll
                for (int bj = 0; bj < 2; ++bj)
#pragma unroll
                    for (int n = 0; n < 2; ++n) { const f32x4 bs = *(const f32x4*)(base + off + bj * HALF + n * 16); acc[ai][bj][m][n] = bs + (acc[ai][bj][m][n] - sr.x) * sr.y; }
                asm volatile("" : "+v"(acc[ai][0][m][0]), "+v"(acc[ai][0][m][1]), "+v"(acc[ai][1][m][0]), "+v"(acc[ai][1][m][1]));
                if (m & 1) asm volatile("" ::: "memory"); }
        const bool bad1 = bad;
        bad = st2.run(acc, u, wr, wc, fr, fq, lds, wid, lane) || bad;
#pragma unroll
        for (int ai = 0; ai < 2; ++ai)
#pragma unroll
            for (int m = 0; m < 4; ++m) { const int r = ai * HALF + wr * 64 + m * 16 + fr; const f32x2v sr = S[r]; const size_t off = (size_t)(u.pm * BM + r) * ldc + col0;
#pragma unroll
                for (int bj = 0; bj < 2; ++bj)
#pragma unroll
                    for (int n = 0; n < 2; ++n) { const f32x4 x1 = acc[ai][bj][m][n]; *(f32x4*)(out + off + bj * HALF + n * 16) = bad1 ? (f32x4){qnan, qnan, qnan, qnan} : x1;
                        const f32x4 o = (x1 - sr.x) * sr.y; u32x2v w; w.x = cvt_pk_bf16(o[0], o[1]); w.y = cvt_pk_bf16(o[2], o[3]);
                        if (bad) { w.x = 0x7fc07fc0u; w.y = 0x7fc07fc0u; } *(u32x2v*)(xn + off + bj * HALF + n * 16) = w; }
                asm volatile("" ::: "memory"); }
    }
};

template <class Epi, class Sched, bool ALIGN_EPI = false, bool SP2 = false>
__device__ __forceinline__ void gemm_phase(PG8_LAS unsigned char* lds, const Gemm g, const Sched& S, const Epi& E) {
    const int tid = mk_tid(), wid = __builtin_amdgcn_readfirstlane(tid >> 6), lane = tid & 63, wr = wid >> 2, wc = wid & 3, fr = lane & 15, fq = lane >> 4;
    const int K = g.K, nt = K / BK;
    unsigned voffA[2], voffB[2];
#pragma unroll
    for (int i = 0; i < 2; ++i) { int R, C; stage_rc(tid * 16 + i * 8192, R, C); const int Rb = Epi::PERM ? ((R & ~31) + perm32(R & 31)) : R;
        voffA[i] = (unsigned)(R * K + C) * 2u; voffB[i] = (unsigned)(Rb * K + C) * 2u; }
    const size_t kstep = (size_t)(BK * 2);
    const size_t hstep = (size_t)HALF * K * 2;
    const size_t tstep = 2 * hstep;
    const unsigned ldsw = (unsigned)wid * 1024u;
    const int aoff = lds_byte(wr * 64 + fr, fq * 8), boff = lds_byte(wc * 32 + fr, fq * 8);
#define PG8_SA(b, h) (((b) * 2 + (h)) * HTB)
#define PG8_SB(b, h) ((4 + (b) * 2 + (h)) * HTB)
#define PG8_STAGE(bufoff, gbase, voff) do { _Pragma("unroll") for (int _i = 0; _i < 2; ++_i) \
        __builtin_amdgcn_global_load_lds((const unsigned*)((const char*)(gbase) + (voff)[_i]), (PG8_LAS unsigned*)(lds + (bufoff) + ldsw + _i * 8192), 16, 0, 0); } while (0)
#define PG8_LDA(dst, b, h) do { _Pragma("unroll") for (int m = 0; m < 4; ++m) _Pragma("unroll") for (int k = 0; k < 2; ++k) dst[m][k] = *(const PG8_LAS bf16x8*)(lds + PG8_SA(b, h) + aoff + m * 2048 + k * 1024); } while (0)
#define PG8_LDB(dst, b, h) do { _Pragma("unroll") for (int n = 0; n < 2; ++n) _Pragma("unroll") for (int k = 0; k < 2; ++k) dst[n][k] = *(const PG8_LAS bf16x8*)(lds + PG8_SB(b, h) + boff + n * 2048 + k * 1024); } while (0)
#define PG8_MMA(ai, bj, At, Bt) do { __builtin_amdgcn_s_setprio(1); _Pragma("unroll") for (int m = 0; m < 4; ++m) _Pragma("unroll") for (int n = 0; n < 2; ++n) _Pragma("unroll") for (int k = 0; k < 2; ++k) \
        acc[ai][bj][m][n] = __builtin_amdgcn_mfma_f32_16x16x32_bf16(Bt[n][k], At[m][k], acc[ai][bj][m][n], 0, 0, 0); __builtin_amdgcn_s_setprio(0); } while (0)
#define PG8_WAIT_V(n) asm volatile("s_waitcnt vmcnt(" #n ")" ::: "memory")
#define PG8_WAIT_L(n) asm volatile("s_waitcnt lgkmcnt(" #n ")" ::: "memory")
#define PG8_BAR __builtin_amdgcn_s_barrier()
#define PG8_SCHED __builtin_amdgcn_sched_barrier(0)
    Unit cur, nxt; int ui = 0;
    if (!S.next(0, cur)) return;
    f32x4 acc[2][2][4][2];
#pragma unroll
    for (int a = 0; a < 2; ++a)
#pragma unroll
        for (int b = 0; b < 2; ++b)
#pragma unroll
            for (int m = 0; m < 4; ++m)
#pragma unroll
                for (int n = 0; n < 2; ++n) acc[a][b][m][n] = (f32x4){0.f, 0.f, 0.f, 0.f};
    bf16x8 At[4][2], B0[2][2], B1[2][2];
    const char* cA = (const char*)g.A + (size_t)cur.pm * tstep; const char* cB = (const char*)g.Bt + (size_t)cur.pn * tstep;
    S.a_ready(cur);
    if constexpr (SP2) {
        PG8_STAGE(PG8_SB(0, 0), cB, voffB); PG8_STAGE(PG8_SB(0, 1), cB + hstep, voffB); PG8_STAGE(PG8_SA(0, 0), cA, voffA); PG8_STAGE(PG8_SA(0, 1), cA + hstep, voffA);
        if (wr == 1) PG8_BAR;
        PG8_WAIT_V(2); PG8_BAR;
        PG8_STAGE(PG8_SB(1, 0), cB + kstep, voffB); PG8_STAGE(PG8_SA(1, 0), cA + kstep, voffA); PG8_STAGE(PG8_SB(1, 1), cB + hstep + kstep, voffB);
        PG8_WAIT_V(6); PG8_BAR;
    } else {
        PG8_STAGE(PG8_SB(0, 0), cB, voffB); PG8_STAGE(PG8_SA(0, 0), cA, voffA); PG8_STAGE(PG8_SB(0, 1), cB + hstep, voffB); PG8_STAGE(PG8_SA(0, 1), cA + hstep, voffA);
        if (wr == 1) PG8_BAR;
        PG8_WAIT_V(4); PG8_BAR;
        PG8_STAGE(PG8_SB(1, 0), cB + kstep, voffB); PG8_STAGE(PG8_SA(1, 0), cA + kstep, voffA); PG8_STAGE(PG8_SB(1, 1), cB + hstep + kstep, voffB);
        PG8_WAIT_V(6); PG8_BAR;
    }
    for (;;) {
        const bool has_next = S.next(ui + 1, nxt);
        const char* nA = has_next ? (const char*)g.A + (size_t)nxt.pm * tstep : cA; const char* nB = has_next ? (const char*)g.Bt + (size_t)nxt.pn * tstep : cB;
        for (int t = 0; t < nt; t += 2) {
            const bool last = (t == nt - 2);
            const char* a1 = cA + (size_t)(t + 1) * kstep;
            const char* a2 = last ? nA : cA + (size_t)(t + 2) * kstep; const char* b2 = last ? nB : cB + (size_t)(t + 2) * kstep;
            const char* a3 = a2 + kstep; const char* b3 = b2 + kstep;
            if (last && has_next) S.a_ready(nxt);
            if constexpr (SP2) {
            PG8_LDB(B0, 0, 0); PG8_LDB(B1, 0, 1); PG8_SCHED; PG8_LDA(At, 0, 0); PG8_STAGE(PG8_SA(1, 1), a1 + hstep, voffA);
            PG8_WAIT_V(8); PG8_WAIT_L(0); PG8_BAR; PG8_MMA(0, 0, At, B0); PG8_MMA(0, 1, At, B1); PG8_BAR; PG8_SCHED;
            PG8_LDA(At, 0, 1); PG8_STAGE(PG8_SB(0, 0), b2, voffB); PG8_STAGE(PG8_SB(0, 1), b2 + hstep, voffB); PG8_STAGE(PG8_SA(0, 0), a2, voffA);
            PG8_WAIT_V(8); PG8_WAIT_L(0); PG8_BAR; PG8_MMA(1, 0, At, B0); PG8_MMA(1, 1, At, B1); PG8_BAR; PG8_SCHED;
            PG8_LDB(B0, 1, 0); PG8_LDB(B1, 1, 1); PG8_SCHED; PG8_LDA(At, 1, 0); PG8_STAGE(PG8_SA(0, 1), a2 + hstep, voffA);
            PG8_WAIT_V(8); PG8_WAIT_L(0); PG8_BAR; PG8_MMA(0, 0, At, B0); PG8_MMA(0, 1, At, B1); PG8_BAR; PG8_SCHED;
            PG8_LDA(At, 1, 1); PG8_STAGE(PG8_SB(1, 0), b3, voffB); PG8_STAGE(PG8_SB(1, 1), b3 + hstep, voffB); PG8_STAGE(PG8_SA(1, 0), a3, voffA);
            PG8_WAIT_V(8); PG8_WAIT_L(0); PG8_BAR; PG8_MMA(1, 0, At, B0); PG8_MMA(1, 1, At, B1); PG8_BAR; PG8_SCHED;
            } else {
            PG8_LDB(B0, 0, 0); PG8_SCHED; PG8_LDA(At, 0, 0); PG8_STAGE(PG8_SA(1, 1), a1 + hstep, voffA);
            PG8_WAIT_L(8); PG8_BAR; PG8_WAIT_L(0); PG8_MMA(0, 0, At, B0); PG8_BAR; PG8_SCHED;
            PG8_LDB(B1, 0, 1); PG8_STAGE(PG8_SB(0, 0), b2, voffB);
            PG8_BAR; PG8_WAIT_L(0); PG8_MMA(0, 1, At, B1); PG8_BAR;
            PG8_LDA(At, 0, 1); PG8_STAGE(PG8_SA(0, 0), a2, voffA);
            PG8_BAR; PG8_WAIT_L(0); PG8_MMA(1, 0, At, B0); PG8_BAR; PG8_SCHED;
            PG8_STAGE(PG8_SB(0, 1), b2 + hstep, voffB);
            PG8_WAIT_V(6); PG8_BAR; PG8_MMA(1, 1, At, B1); PG8_BAR;
            PG8_LDB(B0, 1, 0); PG8_SCHED; PG8_LDA(At, 1, 0); PG8_STAGE(PG8_SA(0, 1), a2 + hstep, voffA);
            PG8_WAIT_L(8); PG8_BAR; PG8_WAIT_L(0); PG8_MMA(0, 0, At, B0); PG8_BAR; PG8_SCHED;
            PG8_LDB(B1, 1, 1); PG8_STAGE(PG8_SB(1, 0), b3, voffB);
            PG8_BAR; PG8_WAIT_L(0); PG8_MMA(0, 1, At, B1); PG8_BAR;
            PG8_LDA(At, 1, 1); PG8_STAGE(PG8_SA(1, 0), a3, voffA);
            PG8_BAR; PG8_WAIT_L(0); PG8_MMA(1, 0, At, B0); PG8_BAR; PG8_SCHED;
            PG8_STAGE(PG8_SB(1, 1), b3 + hstep, voffB);
            PG8_WAIT_V(6); PG8_BAR; PG8_MMA(1, 1, At, B1); PG8_BAR;
            }
        }
        if constexpr (ALIGN_EPI) { if (wr == 0) PG8_BAR; }
        if constexpr (!Epi::AFTER_DRAIN) { E(acc, cur, wr, wc, fr, fq); S.done(cur); }
        if (!has_next) break;
#pragma unroll
        for (int a = 0; a < 2; ++a)
#pragma unroll
            for (int b = 0; b < 2; ++b)
#pragma unroll
                for (int m = 0; m < 4; ++m)
#pragma unroll
                    for (int n = 0; n < 2; ++n) acc[a][b][m][n] = (f32x4){0.f, 0.f, 0.f, 0.f};
        cur = nxt; cA = nA; cB = nB; ++ui;
        if constexpr (ALIGN_EPI) { if (wr == 1) PG8_BAR; }
    }
    PG8_WAIT_V(0);
    if constexpr (!ALIGN_EPI) { if (wr == 0) PG8_BAR; }
    PG8_BAR;
    if constexpr (Epi::AFTER_DRAIN) { E.fused(acc, cur, wr, wc, fr, fq, lds, wid, lane); S.done(cur); }
#undef PG8_SA
#undef PG8_SB
#undef PG8_STAGE
#undef PG8_LDA
#undef PG8_LDB
#undef PG8_MMA
#undef PG8_WAIT_V
#undef PG8_WAIT_L
#undef PG8_BAR
#undef PG8_SCHED
}
}

namespace pg8 {
template <int ACT> struct EpiBf16R {
    static constexpr bool PERM = true, AFTER_DRAIN = false;
    bf16_t* O; int ldc, pad;
    __device__ __forceinline__ void operator()(const f32x4 (&acc)[2][2][4][2], const Unit& u, int wr, int wc, int fr, int fq) const {
        const int row0 = u.pm * BM + wr * 64 + fr; const int col0 = u.pn * BM + wc * 32 + 8 * fq;
#pragma unroll
        for (int ai = 0; ai < 2; ++ai)
#pragma unroll
            for (int m = 0; m < 4; ++m) { bf16_t* rowp = O + (size_t)(row0 + ai * HALF + m * 16) * ldc + col0;
#pragma unroll
                for (int bj = 0; bj < 2; ++bj) { f32x4 v0 = acc[ai][bj][m][0], v1 = acc[ai][bj][m][1];
                    if (ACT == 2) {
#pragma unroll
                        for (int e = 0; e < 4; ++e) { float a = v0[e] > 0.f ? v0[e] : 0.f; v0[e] = a * a; float b = v1[e] > 0.f ? v1[e] : 0.f; v1[e] = b * b; } }
                    u32x4 w; w.x = cvt_pk_bf16(v0[0], v0[1]); w.y = cvt_pk_bf16(v0[2], v0[3]); w.z = cvt_pk_bf16(v1[0], v1[1]); w.w = cvt_pk_bf16(v1[2], v1[3]);
                    *(u32x4*)(rowp + bj * HALF) = w; } }
    }
};
struct EpiF32 {
    static constexpr bool PERM = false, AFTER_DRAIN = false;
    float* O; int ldc, pad;
    __device__ __forceinline__ void operator()(const f32x4 (&acc)[2][2][4][2], const Unit& u, int wr, int wc, int fr, int fq) const {
        const int col0 = u.pn * BM + wc * 32 + 4 * fq;
#pragma unroll
        for (int ai = 0; ai < 2; ++ai)
#pragma unroll
            for (int m = 0; m < 4; ++m) { const size_t off = (size_t)(u.pm * BM + ai * HALF + wr * 64 + m * 16 + fr) * ldc + col0;
#pragma unroll
                for (int bj = 0; bj < 2; ++bj)
#pragma unroll
                    for (int n = 0; n < 2; ++n) *(f32x4*)(O + off + bj * HALF + n * 16) = acc[ai][bj][m][n]; }
    }
};
}

namespace mk {
typedef unsigned short bf16;
typedef short bf16x8 __attribute__((ext_vector_type(8)));
typedef short s16x4 __attribute__((ext_vector_type(4)));
typedef float f32x4 __attribute__((ext_vector_type(4)));
typedef float f32x16 __attribute__((ext_vector_type(16)));
typedef unsigned u32x4 __attribute__((ext_vector_type(4)));
typedef unsigned u32x2 __attribute__((ext_vector_type(2)));
#define MK_LAS __attribute__((address_space(3)))

constexpr int BATCH = 4, SEQ = 8192, DM = 1024, DFF = 4096, MROWS = BATCH * SEQ, NPROJ = 3072, PIN = 3076, DEPTH = 2, NT = 512;
constexpr float EPS = 1e-6f, LOG2E = 1.4426950408889634f, NEGS = -30000.f, MINIT = -10000.f;
constexpr int PA_Q = 0, PA_K = 256, PA_V = 512, PB_G = 768, PB_X = 1024, PC_Z = 1280, PC_XBC = 1536, PD_Q = 2304, PD_K = 2560, PD_V = 2816;
constexpr int MX_A = 0, MX_B = 256, MX_C = 512, MX_D = 768;

constexpr size_t MiB = 1u << 20;
constexpr size_t WS_CTL = 0, WS_TBL = 1 * MiB, WS_W = 2 * MiB, W_LAYER = 24 * MiB, WS_DT = 52 * MiB, WS_LSUM = 53 * MiB, WS_CDEC = 54 * MiB,
                 WS_XN = 64 * MiB, WS_PROJ = 128 * MiB, WS_MIX = 320 * MiB, WS_HID = 128 * MiB, WS_Y1 = 128 * MiB, WS_Y2 = 384 * MiB, WS_ST = 384 * MiB, WS_CONV = 448 * MiB, WS_END = 512 * MiB;
constexpr size_t WO_IN = 0, WO_OUT = 6 * MiB, WO_UP = 8 * MiB, WO_DOWN = 16 * MiB;
constexpr size_t TB_D = 0  , TB_A = 32768  , TB_LAM = 40960  , TB_LRUW = 65536  ;
constexpr int LDS_BYTES = 147456;

enum { I_X = 0, I_RELB, I_NMPRE, I_NMPOST, I_NFPRE, I_NFPOST, I_WIN, I_WOUT, I_LCW, I_LCB, I_LWA, I_LBA, I_LWX, I_LBX, I_LLAM,
       I_SCW, I_SCB, I_SDTB, I_SALOG, I_SD, I_SNORM, I_LQ1, I_LK1, I_LQ2, I_LK2, I_DNORM, I_WUP, I_WDOWN, N_IN };
struct Params { const float* in[N_IN]; float* out; unsigned char* ws; };

__device__ __forceinline__ unsigned f2bf(float f) { unsigned u = __float_as_uint(f); return (u + 0x7fffu + ((u >> 16) & 1u)) >> 16; }
__device__ __forceinline__ float bf2f(unsigned short b) { return __uint_as_float(((unsigned)b) << 16); }
__device__ __forceinline__ unsigned pk2(float lo, float hi) { return f2bf(lo) | (f2bf(hi) << 16); }
__device__ __forceinline__ int crow(int r, int hi) { return (r & 3) + 8 * (r >> 2) + 4 * hi; }
__device__ __forceinline__ float wave_sum(float v) {
#pragma unroll
    for (int o = 1; o < 64; o <<= 1) v += __shfl_xor(v, o);
    return v;
}
__device__ __forceinline__ int t5_bucket(int n) {
    if (n < 16) return n;
    return 16 + (n >= 22) + (n >= 30) + (n >= 40) + (n >= 54) + (n >= 73) + (n >= 99) + (n >= 134) + (n >= 182) + (n >= 246) + (n >= 332) + (n >= 450) + (n >= 609) + (n >= 825) + (n >= 1117) + (n >= 1513);
}
__device__ __forceinline__ f32x16 mfma32(bf16x8 a, bf16x8 b, f32x16 c) { return __builtin_amdgcn_mfma_f32_32x32x16_bf16(a, b, c, 0, 0, 0); }
__device__ __forceinline__ bf16x8 pack8(const f32x16& p, int base) {
    u32x4 w; w.x = pk2(p[base + 0], p[base + 1]); w.y = pk2(p[base + 2], p[base + 3]); w.z = pk2(p[base + 4], p[base + 5]); w.w = pk2(p[base + 6], p[base + 7]);
    return __builtin_bit_cast(bf16x8, w);
}
typedef short v4i16_t __attribute__((ext_vector_type(4)));
__device__ __forceinline__ s16x4 vtr(const unsigned char* p) {
    return __builtin_bit_cast(s16x4, __builtin_amdgcn_ds_read_tr16_b64_v4i16((MK_LAS v4i16_t*)(p)));
}
__device__ __forceinline__ bf16x8 vfrag(const unsigned char* p) {
    const s16x4 lo = vtr(p), hi = vtr(p + 512);
    return (bf16x8){lo[0], lo[1], lo[2], lo[3], hi[0], hi[1], hi[2], hi[3]};
}
#define MK_LDSFENCE() asm volatile("s_waitcnt lgkmcnt(0)" ::: "memory")

__device__ __forceinline__ void tr_item(const float* W, int K, int Nsrc, bf16* WT, int k0, int n0, bool remap, float* scr, int tid) {
    const int c = tid & 63, r0 = tid >> 6;
#pragma unroll
    for (int i = 0; i < 8; ++i) { const int k = r0 + 8 * i; const int n = n0 + c; const int sn = (remap && n >= 2304) ? n + 4 : n; scr[k * 65 + c] = W[(size_t)(k0 + k) * Nsrc + sn]; }
    __syncthreads();
#pragma unroll
    for (int i = 0; i < 8; ++i) { const int n = r0 + 8 * i; WT[(size_t)(n0 + n) * K + k0 + c] = (bf16)f2bf(scr[c * 65 + n]); }
    __syncthreads();
}
__device__ __forceinline__ void ph_prep(const Params& P, unsigned char* lds) {
    float* scr = (float*)lds; const int tid = mk_tid();
    constexpr int T_IN = 16 * 48, T_OUT = 16 * 16, T_UP = 16 * 64, T_DOWN = 64 * 16, T_L = T_IN + T_OUT + T_UP + T_DOWN;
    for (int it = blockIdx.x; it < DEPTH * T_L; it += gridDim.x) {
        const int layer = it / T_L; int r = it % T_L; bf16* wl = (bf16*)(P.ws + WS_W + (size_t)layer * W_LAYER);
        if (r < T_IN) { tr_item(P.in[I_WIN] + (size_t)layer * DM * PIN, DM, PIN, wl + WO_IN / 2, (r / 48) * 64, (r % 48) * 64, true, scr, tid); continue; } r -= T_IN;
        if (r < T_OUT) { tr_item(P.in[I_WOUT] + (size_t)layer * DM * DM, DM, DM, wl + WO_OUT / 2, (r / 16) * 64, (r % 16) * 64, false, scr, tid); continue; } r -= T_OUT;
        if (r < T_UP) { tr_item(P.in[I_WUP] + (size_t)layer * DM * DFF, DM, DFF, wl + WO_UP / 2, (r / 64) * 64, (r % 64) * 64, false, scr, tid); continue; } r -= T_UP;
        tr_item(P.in[I_WDOWN] + (size_t)layer * DFF * DM, DFF, DM, wl + WO_DOWN / 2, (r / 16) * 64, (r % 16) * 64, false, scr, tid);
    }
    const int gid = blockIdx.x * NT + tid, gn = gridDim.x * NT;
    const float* rb = P.in[I_RELB];
    float* tD = (float*)(P.ws + WS_TBL + TB_D); float* tA = (float*)(P.ws + WS_TBL + TB_A); float* tL = (float*)(P.ws + WS_TBL + TB_LAM);
    for (int i = gid; i < 4 * 2048; i += gn) { const int h = i >> 11, d = i & 2047; tD[i] = (rb[t5_bucket(d) * 8 + 4 + h] - rb[31 * 8 + 4 + h]) * LOG2E; }
    for (int i = gid; i < 3 * 4 * 132; i += gn) { const int p = i / (4 * 132), h = (i / 132) & 3, j = i % 132; const int dil = p == 0 ? 1 : (p == 1 ? 4 : 16);
        tA[i] = (j <= 128) ? rb[t5_bucket(j * dil) * 8 + h] * LOG2E : NEGS; }
    if (gid < DEPTH) { const int layer = gid; float s1 = 0.f, s2 = 0.f;
        for (int i = 0; i < 32; ++i) { s1 += P.in[I_LQ1][layer * 32 + i] * P.in[I_LK1][layer * 32 + i]; s2 += P.in[I_LQ2][layer * 32 + i] * P.in[I_LK2][layer * 32 + i]; }
        const float lam_init = 0.8f - 0.6f * expf(-0.3f * (float)layer); tL[layer] = expf(s1) - expf(s2) + lam_init; }
    bf16* lw = (bf16*)(P.ws + WS_TBL + TB_LRUW);
    for (int i = gid; i < DEPTH * 2 * 4 * 64 * 64; i += gn) { const int ii = i & 63, j = (i >> 6) & 63, hb = (i >> 12) & 3, g = (i >> 14) & 1, layer = i >> 15;
        const float* src = (g ? P.in[I_LWX] : P.in[I_LWA]) + (size_t)layer * 4 * 64 * 64; lw[i] = (bf16)f2bf(src[(hb * 64 + ii) * 64 + j]); }
}

__device__ __forceinline__ void ph_row(const float* Y, const float* gpost, const float* base, float* hout, const float* gnext, bf16* XN, const float* Wdt, float* DT) {
    const int tid_ = mk_tid(); const int lane = tid_ & 63, gw = blockIdx.x * (NT / 64) + (tid_ >> 6), ngw = gridDim.x * (NT / 64);
    for (int m = gw; m < MROWS; m += ngw) {
        f32x4 hv[4];
        const f32x4* bp = (const f32x4*)(base + (size_t)m * DM) + lane;
#pragma unroll
        for (int j = 0; j < 4; ++j) hv[j] = bp[64 * j];
        if (Y) {
            const f32x4* yp = (const f32x4*)(Y + (size_t)m * DM) + lane; f32x4 y[4]; float ss = 0.f;
#pragma unroll
            for (int j = 0; j < 4; ++j) { y[j] = yp[64 * j]; ss += (y[j].x * y[j].x + y[j].y * y[j].y) + (y[j].z * y[j].z + y[j].w * y[j].w); }
            ss = wave_sum(ss); const float r = 1.0f / sqrtf(ss * (1.0f / DM) + EPS);
            const f32x4* gp = (const f32x4*)gpost + lane; f32x4* hp = (f32x4*)(hout + (size_t)m * DM) + lane;
#pragma unroll
            for (int j = 0; j < 4; ++j) { hv[j] = hv[j] + y[j] * r * gp[64 * j]; hp[64 * j] = hv[j]; }
        }
        if (gnext) {
            float ss = 0.f;
#pragma unroll
            for (int j = 0; j < 4; ++j) ss += (hv[j].x * hv[j].x + hv[j].y * hv[j].y) + (hv[j].z * hv[j].z + hv[j].w * hv[j].w);
            ss = wave_sum(ss); const float r = 1.0f / sqrtf(ss * (1.0f / DM) + EPS);
            const f32x4* gp = (const f32x4*)gnext + lane; u32x2* xp = (u32x2*)(XN + (size_t)m * DM) + lane;
            f32x4 d = {0.f, 0.f, 0.f, 0.f};
#pragma unroll
            for (int j = 0; j < 4; ++j) { const f32x4 u = hv[j] * r * gp[64 * j]; u32x2 w; w.x = pk2(u.x, u.y); w.y = pk2(u.z, u.w); xp[64 * j] = w;
                if (Wdt) { const float* wp = Wdt + (size_t)(4 * (lane + 64 * j)) * PIN;
                    d = d + u.x * *(const f32x4*)(wp) + u.y * *(const f32x4*)(wp + PIN) + u.z * *(const f32x4*)(wp + 2 * PIN) + u.w * *(const f32x4*)(wp + 3 * PIN); } }
            if (Wdt) { d.x = wave_sum(d.x); d.y = wave_sum(d.y); d.z = wave_sum(d.z); d.w = wave_sum(d.w); if (lane == 0) *(f32x4*)(DT + (size_t)m * 4) = d; }
        }
    }
}

template <class Epi> __device__ __forceinline__ void ph_gemm(const pg8::Gemm g, const Epi e, unsigned char* lds) {
    pg8::StaticOrder S; S.init(g.M, g.N, (int)gridDim.x, (int)blockIdx.x);
    pg8::gemm_phase<Epi, pg8::StaticOrder, true, true>((PG8_LAS unsigned char*)lds, g, S, e);
}

__device__ __forceinline__ void ph_dilated(const Params& P, unsigned char* lds) {
    const int tid = mk_tid(), lane = tid & 63, wid = tid >> 6, r32 = lane & 31, hi = lane >> 5;
    float* tbl = (float*)lds;
    unsigned char* vst = lds + 13824 + wid * 4352;
    float* scr = (float*)(vst + 4096);
    const bf16* PROJ = (const bf16*)(P.ws + WS_PROJ); bf16* MIX = (bf16*)(P.ws + WS_MIX);
    const float* tA = (const float*)(P.ws + WS_TBL + TB_A);
    for (int item = blockIdx.x; item < 512; item += gridDim.x) {
        const int half = item & 1, chunk = (item >> 1) & 15, h = (item >> 5) & 3, b = item >> 7;
        __syncthreads();
        for (int i = tid; i < 3 * 1152; i += NT) { const int p = i / 1152, j = (i % 1152) - 496; tbl[i] = (j >= 0 && j <= 128) ? tA[(p * 4 + h) * 132 + j] : NEGS; }
        __syncthreads();
        const int rres = half * 8 + wid, T0 = chunk * 512, Tmax = T0 + rres + 496;
        const bf16* base = PROJ + (size_t)b * SEQ * NPROJ;
        bf16x8 qf[4];
        { const bf16* qp = base + (size_t)(T0 + rres + 16 * r32) * NPROJ + PA_Q + h * 64 + hi * 8; const float c2 = 0.125f * LOG2E;
#pragma unroll
          for (int s = 0; s < 4; ++s) { const bf16x8 q = *(const bf16x8*)(qp + 16 * s); u32x4 w;
              w.x = pk2(bf2f((bf16)q[0]) * c2, bf2f((bf16)q[1]) * c2); w.y = pk2(bf2f((bf16)q[2]) * c2, bf2f((bf16)q[3]) * c2);
              w.z = pk2(bf2f((bf16)q[4]) * c2, bf2f((bf16)q[5]) * c2); w.w = pk2(bf2f((bf16)q[6]) * c2, bf2f((bf16)q[7]) * c2); qf[s] = __builtin_bit_cast(bf16x8, w); } }
        float m = MINIT, l = 0.f; f32x16 o0 = {}, o1 = {};
        for (int p = 0; p < 3; ++p) {
            const int dl = p == 0 ? 1 : (p == 1 ? 4 : 16), rho = 16 / dl, ntile = (rho * 31 + 128) / 32 + 1, kmaxp = Tmax / dl, kq = rho * (31 - r32);
            for (int tau = 0; tau < ntile; ++tau) {
                const int k0 = 32 * tau;
                bf16x8 kf[4];
                { int pos = Tmax - dl * (k0 + r32); pos = pos < 0 ? 0 : pos; const bf16* kp = base + (size_t)pos * NPROJ + PA_K + h * 64 + hi * 8;
#pragma unroll
                  for (int s = 0; s < 4; ++s) kf[s] = *(const bf16x8*)(kp + 16 * s); }
#pragma unroll
                for (int i = 0; i < 4; ++i) { const int ci = lane + 64 * i, krow = ci >> 3, ch = ci & 7; int pos = Tmax - dl * (k0 + krow); pos = pos < 0 ? 0 : pos;
                    const bf16x8 v = *(const bf16x8*)(base + (size_t)pos * NPROJ + PA_V + h * 64 + ch * 8);
                    *(bf16x8*)(vst + ((ch >> 2) * 2 + (krow >> 4)) * 1024 + (krow & 15) * 64 + (ch & 3) * 16) = v; }
                f32x16 acc;
                { const float* tb = tbl + p * 1152 + (k0 + 4 * hi - kq + 496);
#pragma unroll
                  for (int r = 0; r < 16; ++r) acc[r] = tb[(r & 3) + 8 * (r >> 2)]; }
#pragma unroll
                for (int s = 0; s < 4; ++s) acc = mfma32(kf[s], qf[s], acc);
#pragma unroll
                for (int r = 0; r < 16; ++r) if (k0 + crow(r, hi) > kmaxp) acc[r] = NEGS;
                float mx = acc[0];
#pragma unroll
                for (int r = 1; r < 16; ++r) mx = fmaxf(mx, acc[r]);
                mx = fmaxf(mx, __shfl_xor(mx, 32));
                const float mn = fmaxf(m, mx), f = exp2f(m - mn); m = mn;
                float ps = 0.f;
#pragma unroll
                for (int r = 0; r < 16; ++r) { acc[r] = exp2f(acc[r] - mn); ps += acc[r]; }
                l = l * f + ps;
                if (__any(f != 1.0f)) {
                    if (hi == 0) scr[r32] = f;
                    MK_LDSFENCE();
#pragma unroll
                    for (int r = 0; r < 16; ++r) { const float fr = scr[crow(r, hi)]; o0[r] *= fr; o1[r] *= fr; }
                }
                MK_LDSFENCE();
                const unsigned char* vb = vst + ((lane >> 4) & 1) * 32 + (lane & 3) * 8 + (4 * hi + ((lane & 15) >> 2)) * 64;
#pragma unroll
                for (int ks = 0; ks < 2; ++ks) { const bf16x8 pa = pack8(acc, 8 * ks);
                    o0 = mfma32(pa, vfrag(vb + ks * 1024), o0); o1 = mfma32(pa, vfrag(vb + 2048 + ks * 1024), o1); }
                MK_LDSFENCE();
            }
        }
        l += __shfl_xor(l, 32);
        if (hi == 0) scr[r32] = 1.0f / l;
        MK_LDSFENCE();
#pragma unroll
        for (int r = 0; r < 16; ++r) { const int q = crow(r, hi); const float inv = scr[q];
            bf16* op = MIX + ((size_t)b * SEQ + T0 + rres + 16 * q) * DM + MX_A + h * 64 + r32;
            op[0] = (bf16)f2bf(o0[r] * inv); op[32] = (bf16)f2bf(o1[r] * inv); }
        MK_LDSFENCE();
    }
}

__device__ __forceinline__ void diff_unit(const Params& P, int layer, int b, int h, int qb, unsigned char* lds) {
    const int tid = mk_tid(), lane = tid & 63, wid = tid >> 6, r32 = lane & 31, hi = lane >> 5;
    unsigned char* Kb = lds;
    unsigned char* Vb = lds + 16384;
    const float* tbl = (const float*)(lds + 32768);
    float* scr = (float*)(lds + 40960) + wid * 64;
    const bf16* PROJ = (const bf16*)(P.ws + WS_PROJ); bf16* MIX = (bf16*)(P.ws + WS_MIX);
    const bf16* base = PROJ + (size_t)b * SEQ * NPROJ;
    const int q0 = qb * 256, qw0 = q0 + 32 * wid, qabs = qw0 + r32, NTL = 4 * qb + 4;
    bf16x8 qf[2][2];
    { const bf16* qp = base + (size_t)qabs * NPROJ + PD_Q + h * 64 + hi * 8; const float c2 = 0.17677669529663687f * LOG2E;
#pragma unroll
      for (int c = 0; c < 2; ++c)
#pragma unroll
          for (int s = 0; s < 2; ++s) { const bf16x8 q = *(const bf16x8*)(qp + c * 32 + 16 * s); u32x4 w;
              w.x = pk2(bf2f((bf16)q[0]) * c2, bf2f((bf16)q[1]) * c2); w.y = pk2(bf2f((bf16)q[2]) * c2, bf2f((bf16)q[3]) * c2);
              w.z = pk2(bf2f((bf16)q[4]) * c2, bf2f((bf16)q[5]) * c2); w.w = pk2(bf2f((bf16)q[6]) * c2, bf2f((bf16)q[7]) * c2); qf[c][s] = __builtin_bit_cast(bf16x8, w); } }
    const int lrow = tid >> 3, lch = tid & 7;
    const bf16* kg = base + (size_t)lrow * NPROJ + PD_K + h * 64 + lch * 8;
    const bf16* vg = base + (size_t)lrow * NPROJ + PD_V + h * 64 + lch * 8;
    const int kdst = lrow * 128 + ((lch ^ (lrow & 7)) * 16), vdst = ((lch >> 2) * 4 + (lrow >> 4)) * 1024 + (lrow & 15) * 64 + (lch & 3) * 16;
    { const bf16x8 k = *(const bf16x8*)kg, v = *(const bf16x8*)vg; *(bf16x8*)(Kb + kdst) = k; *(bf16x8*)(Vb + vdst) = v; }
    float m[2] = {MINIT, MINIT}, l[2] = {0.f, 0.f}; f32x16 o[2][2]; o[0][0] = f32x16{}; o[0][1] = f32x16{}; o[1][0] = f32x16{}; o[1][1] = f32x16{};
    __syncthreads();
    for (int j = 0; j < NTL; ++j) {
        bf16x8 kn = {}, vn = {};
        if (j + 1 < NTL) { kn = *(const bf16x8*)(kg + (size_t)(j + 1) * 64 * NPROJ); vn = *(const bf16x8*)(vg + (size_t)(j + 1) * 64 * NPROJ); }
        const int k0 = 64 * j;
        if (k0 <= qw0 + 31) {
            const unsigned char* Kt = Kb + (j & 1) * 8192; const unsigned char* Vt = Vb + (j & 1) * 8192;
            f32x16 sc[2][2];
            const bool near = (qw0 - k0 - 63) < 1513;
#pragma unroll
            for (int kh = 0; kh < 2; ++kh) {
                f32x16 init = {};
                if (near) { const int dq = qabs - k0 - 32 * kh - 4 * hi;
#pragma unroll
                    for (int r = 0; r < 16; ++r) { int d = dq - ((r & 3) + 8 * (r >> 2)); d = d < 0 ? 0 : d; init[r] = tbl[d]; } }
                const int key = 32 * kh + r32; const unsigned char* kr = Kt + key * 128;
#pragma unroll
                for (int c = 0; c < 2; ++c) { f32x16 a = init;
#pragma unroll
                    for (int s = 0; s < 2; ++s) { const int chunk = c * 4 + 2 * s + hi; a = mfma32(*(const bf16x8*)(kr + ((chunk ^ (key & 7)) * 16)), qf[c][s], a); }
                    sc[c][kh] = a; }
            }
            if (k0 + 63 > qw0) {
#pragma unroll
                for (int kh = 0; kh < 2; ++kh)
#pragma unroll
                    for (int r = 0; r < 16; ++r) if (k0 + 32 * kh + crow(r, hi) > qabs) { sc[0][kh][r] = NEGS; sc[1][kh][r] = NEGS; }
            }
            float fsc[2];
#pragma unroll
            for (int c = 0; c < 2; ++c) {
                float mx = sc[c][0][0];
#pragma unroll
                for (int r = 1; r < 16; ++r) mx = fmaxf(mx, sc[c][0][r]);
#pragma unroll
                for (int r = 0; r < 16; ++r) mx = fmaxf(mx, sc[c][1][r]);
                mx = fmaxf(mx, __shfl_xor(mx, 32));
                const float mn = fmaxf(m[c], mx), f = exp2f(m[c] - mn); m[c] = mn; fsc[c] = f;
                float ps = 0.f;
#pragma unroll
                for (int r = 0; r < 16; ++r) { sc[c][0][r] = exp2f(sc[c][0][r] - mn); ps += sc[c][0][r]; }
#pragma unroll
                for (int r = 0; r < 16; ++r) { sc[c][1][r] = exp2f(sc[c][1][r] - mn); ps += sc[c][1][r]; }
                l[c] = l[c] * f + ps;
            }
            if (__any(fsc[0] != 1.0f || fsc[1] != 1.0f)) {
                if (hi == 0) { scr[r32] = fsc[0]; scr[32 + r32] = fsc[1]; }
                MK_LDSFENCE();
#pragma unroll
                for (int r = 0; r < 16; ++r) { const int q = crow(r, hi); const float f0 = scr[q], f1 = scr[32 + q];
                    o[0][0][r] *= f0; o[0][1][r] *= f0; o[1][0][r] *= f1; o[1][1][r] *= f1; }
                MK_LDSFENCE();
            }
            const unsigned char* vb = Vt + ((lane >> 4) & 1) * 32 + (lane & 3) * 8 + (4 * hi + ((lane & 15) >> 2)) * 64;
#pragma unroll
            for (int ks = 0; ks < 4; ++ks) {
                const bf16x8 v0 = vfrag(vb + ks * 1024), v1 = vfrag(vb + 4096 + ks * 1024);
                const bf16x8 p0 = pack8(sc[0][ks >> 1], 8 * (ks & 1)), p1 = pack8(sc[1][ks >> 1], 8 * (ks & 1));
                o[0][0] = mfma32(p0, v0, o[0][0]); o[0][1] = mfma32(p0, v1, o[0][1]);
                o[1][0] = mfma32(p1, v0, o[1][0]); o[1][1] = mfma32(p1, v1, o[1][1]);
            }
        }
        if (j + 1 < NTL) { *(bf16x8*)(Kb + ((j + 1) & 1) * 8192 + kdst) = kn; *(bf16x8*)(Vb + ((j + 1) & 1) * 8192 + vdst) = vn; }
        __syncthreads();
    }
    const float lam = ((const float*)(P.ws + WS_TBL + TB_LAM))[layer];
    const float lam_init = 0.8f - 0.6f * expf(-0.3f * (float)layer);
    l[0] += __shfl_xor(l[0], 32); l[1] += __shfl_xor(l[1], 32);
    if (hi == 0) { scr[r32] = 1.0f / l[0]; scr[32 + r32] = lam / l[1]; }
    MK_LDSFENCE();
    const float* gn = P.in[I_DNORM] + layer * 64;
    const float g0 = gn[r32] * (1.0f - lam_init), g1 = gn[32 + r32] * (1.0f - lam_init);
#pragma unroll
    for (int r = 0; r < 16; ++r) { const int q = crow(r, hi); const float i0 = scr[q], i1 = scr[32 + q];
        const float a = o[0][0][r] * i0 - o[1][0][r] * i1, c = o[0][1][r] * i0 - o[1][1][r] * i1;
        float ss = a * a + c * c;
#pragma unroll
        for (int x = 1; x < 32; x <<= 1) ss += __shfl_xor(ss, x);
        const float rs = 1.0f / sqrtf(ss * (1.0f / 64.0f) + EPS);
        bf16* op = MIX + ((size_t)b * SEQ + qw0 + q) * DM + MX_D + h * 64 + r32;
        op[0] = (bf16)f2bf(a * rs * g0); op[32] = (bf16)f2bf(c * rs * g1); }
    MK_LDSFENCE();
}
__device__ __forceinline__ void ph_diff(const Params& P, int layer, unsigned char* lds) {
    const float* tD = (const float*)(P.ws + WS_TBL + TB_D);
    for (int item = blockIdx.x; item < 256; item += gridDim.x) {
        const int bh = item >> 4, s = item & 15, b = bh >> 2, h = bh & 3;
        __syncthreads();
        for (int i = mk_tid(); i < 2048; i += NT) ((float*)(lds + 32768))[i] = tD[h * 2048 + i];
        __syncthreads();
        diff_unit(P, layer, b, h, 31 - s, lds);
        __syncthreads();
        diff_unit(P, layer, b, h, s, lds);
    }
}

__device__ __forceinline__ float sigm(float v) { return 1.0f / (1.0f + __expf(-v)); }
__device__ __forceinline__ float gelu_tanh(float x) { const float u = 0.7978845608028654f * (x + 0.044715f * x * x * x); return x * sigm(2.0f * u); }
__device__ __forceinline__ bf16x8 pack8f(const float (&o)[8]) { u32x4 w; w.x = pk2(o[0], o[1]); w.y = pk2(o[2], o[3]); w.z = pk2(o[4], o[5]); w.w = pk2(o[6], o[7]); return __builtin_bit_cast(bf16x8, w); }
__device__ __forceinline__ void ph_conv(const Params& P, int layer) {
    const bf16* PROJ = (const bf16*)(P.ws + WS_PROJ); bf16* CONVB = (bf16*)(P.ws + WS_CONV);
    const int gid = blockIdx.x * NT + mk_tid();
    for (int it = gid; it < 128 * (MROWS / 16); it += gridDim.x * NT) {
        const int cg = it & 127, seg = it >> 7, m0 = seg * 16, t = m0 & (SEQ - 1);
        const bool lru = cg < 32;
        const int pcol = lru ? PB_X + 8 * cg : PC_XBC + 8 * (cg - 32);
        const float* cw = lru ? P.in[I_LCW] + layer * 4 * 256 + 8 * cg : P.in[I_SCW] + layer * 4 * 768 + 8 * (cg - 32);
        const float* cb = lru ? P.in[I_LCB] + layer * 256 + 8 * cg : P.in[I_SCB] + layer * 768 + 8 * (cg - 32);
        const int wst = lru ? 256 : 768;
        const f32x4 b0 = *(const f32x4*)cb, b1 = *(const f32x4*)(cb + 4);
        const f32x4 w00 = *(const f32x4*)cw, w01 = *(const f32x4*)(cw + 4), w10 = *(const f32x4*)(cw + wst), w11 = *(const f32x4*)(cw + wst + 4);
        const f32x4 w20 = *(const f32x4*)(cw + 2 * wst), w21 = *(const f32x4*)(cw + 2 * wst + 4), w30 = *(const f32x4*)(cw + 3 * wst), w31 = *(const f32x4*)(cw + 3 * wst + 4);
        const unsigned xo = (unsigned)m0 * NPROJ + pcol;
        const bf16x8 z8 = {0, 0, 0, 0, 0, 0, 0, 0};
        bf16x8 x1 = t >= 1 ? *(const bf16x8*)(PROJ + (xo - NPROJ)) : z8, x2 = t >= 2 ? *(const bf16x8*)(PROJ + (xo - 2 * NPROJ)) : z8, x3 = t >= 3 ? *(const bf16x8*)(PROJ + (xo - 3 * NPROJ)) : z8;
#pragma unroll 4
        for (int i = 0; i < 16; ++i) { const bf16x8 x0 = *(const bf16x8*)(PROJ + (xo + (unsigned)i * NPROJ)); float o[8];
#pragma unroll
            for (int e = 0; e < 4; ++e) {
                o[e] = b0[e] + w00[e] * bf2f((bf16)x3[e]) + w10[e] * bf2f((bf16)x2[e]) + w20[e] * bf2f((bf16)x1[e]) + w30[e] * bf2f((bf16)x0[e]);
                o[4 + e] = b1[e] + w01[e] * bf2f((bf16)x3[4 + e]) + w11[e] * bf2f((bf16)x2[4 + e]) + w21[e] * bf2f((bf16)x1[4 + e]) + w31[e] * bf2f((bf16)x0[4 + e]); }
            if (!lru) {
#pragma unroll
                for (int e = 0; e < 8; ++e) o[e] = o[e] * sigm(o[e]); }
            *(bf16x8*)(CONVB + ((unsigned)(m0 + i) * DM + 8 * cg)) = pack8f(o);
            x3 = x2; x2 = x1; x1 = x0; }
    }
}
template <int pass> __device__ __forceinline__ void ph_lru(const Params& P, int layer) {
    const int tid = mk_tid(), lane = tid & 63, wid = tid >> 6, r32 = lane & 31, hi = lane >> 5;
    const bf16* PROJ = (const bf16*)(P.ws + WS_PROJ); bf16* MIX = (bf16*)(P.ws + WS_MIX);
    float* LSUM = (float*)(P.ws + WS_LSUM); const float* LCAR = (const float*)(P.ws + WS_LSUM + 524288);
    const bf16* CONVB = (const bf16*)(P.ws + WS_CONV);
    const bf16* WT = (const bf16*)(P.ws + WS_TBL + TB_LRUW) + (size_t)layer * 2 * 4 * 64 * 64;
    const int hb = wid >> 1, nt = wid & 1, ch = hb * 64 + 32 * nt + r32;
    bf16x8 wa[4], wx[4];
#pragma unroll
    for (int ks = 0; ks < 4; ++ks) { wa[ks] = *(const bf16x8*)(WT + ((size_t)(hb * 64 + 32 * nt + r32)) * 64 + 16 * ks + 8 * hi);
        wx[ks] = *(const bf16x8*)(WT + ((size_t)((4 + hb) * 64 + 32 * nt + r32)) * 64 + 16 * ks + 8 * hi); }
    bf16x8 idf[2];
#pragma unroll
    for (int kk = 0; kk < 2; ++kk)
#pragma unroll
        for (int e = 0; e < 8; ++e) idf[kk][e] = (r32 == 16 * kk + 8 * hi + e) ? (short)0x3F80 : (short)0;
    const float sp = log1pf(expf(-P.in[I_LLAM][layer * 256 + ch])), bav = P.in[I_LBA][layer * 256 + ch], bxv = P.in[I_LBX][layer * 256 + ch];
    for (int item = blockIdx.x; item < 256; item += gridDim.x) {
        const int b = item >> 6, c = item & 63;
        float hst = 0.f, aprod = 1.f;
        if (pass == 1) hst = LCAR[(unsigned)((b * 64 + c) * 256 + ch)];
#pragma unroll 1
        for (int sc = 0; sc < 4; ++sc) {
            const int tl0 = c * 128 + sc * 32, t = tl0 + r32;
            bf16x8 af[4];
            const unsigned xo = (unsigned)(b * SEQ + t) * DM + hb * 64 + 8 * hi;
#pragma unroll
            for (int ks = 0; ks < 4; ++ks) af[ks] = *(const bf16x8*)(CONVB + (xo + 16 * ks));
            f32x16 accr = {}, acci = {}, accx = {};
#pragma unroll
            for (int ks = 0; ks < 4; ++ks) { accr = mfma32(af[ks], wa[ks], accr); acci = mfma32(af[ks], wx[ks], acci); }
            { const bf16x8 a0 = nt ? af[2] : af[0], a1 = nt ? af[3] : af[1]; accx = mfma32(a0, idf[0], accx); accx = mfma32(a1, idf[1], accx); }
            float av[16], bv[16];
#pragma unroll
            for (int r = 0; r < 16; ++r) { const float rg = sigm(accr[r] + bav), ig = sigm(acci[r] + bxv); const float la = -8.0f * rg * sp; const float a = __expf(la);
                av[r] = a; bv[r] = sqrtf(fmaxf(1.0f - a * a, 0.f)) * (ig * accx[r]); }
            float Ag[4], Hg[4], Ao[4], Ho[4], cin[4];
#pragma unroll
            for (int gi = 0; gi < 4; ++gi) { float A = 1.f, H = 0.f;
#pragma unroll
                for (int e = 0; e < 4; ++e) { H = av[4 * gi + e] * H + bv[4 * gi + e]; A *= av[4 * gi + e]; }
                Ag[gi] = A; Hg[gi] = H; Ao[gi] = __shfl_xor(A, 32); Ho[gi] = __shfl_xor(H, 32); }
            float carry = hst;
#pragma unroll
            for (int gi = 0; gi < 4; ++gi) { const float A0 = hi ? Ao[gi] : Ag[gi], H0 = hi ? Ho[gi] : Hg[gi], A1 = hi ? Ag[gi] : Ao[gi], H1 = hi ? Hg[gi] : Ho[gi];
                const float c0 = carry; carry = A0 * carry + H0; const float c1 = carry; carry = A1 * carry + H1; cin[gi] = hi ? c1 : c0; aprod *= A0 * A1; }
            hst = carry;
            if (pass == 1) {
                const unsigned rowq = (unsigned)(b * SEQ + tl0 + 4 * hi);
#pragma unroll
                for (int gi = 0; gi < 4; ++gi) { float h = cin[gi];
                    asm volatile("" ::: "memory");
#pragma unroll
                    for (int e = 0; e < 4; ++e) { const int r = 4 * gi + e; h = av[r] * h + bv[r]; const unsigned row = rowq + 8 * gi + e;
                        const float g = bf2f(PROJ[row * NPROJ + PB_G + ch]); MIX[row * DM + MX_B + ch] = (bf16)f2bf(gelu_tanh(g) * h); } }
            }
        }
        if (pass == 0 && hi == 0) { LSUM[(unsigned)((b * 64 + c) * 512 + ch)] = aprod; LSUM[(unsigned)((b * 64 + c) * 512 + 256 + ch)] = hst; }
    }
}

__device__ __forceinline__ float softplusf(float v) { return v > 20.f ? v : log1pf(expf(v)); }
__device__ __forceinline__ bf16x8 trfrag(const unsigned char* tile, int ks, int ct, int lane) {
    const unsigned char* p = tile + (16 * ks + 4 * (lane >> 5) + ((lane & 15) >> 2)) * 272 + (32 * ct + 16 * ((lane >> 4) & 1) + 4 * (lane & 3)) * 2;
    const s16x4 lo = vtr(p), hi = vtr(p + 8 * 272);
    return (bf16x8){lo[0], lo[1], lo[2], lo[3], hi[0], hi[1], hi[2], hi[3]};
}
template <int pass> __device__ __forceinline__ void ph_ssd(const Params& P, int layer, unsigned char* lds) {
    const int tid = mk_tid(), lane = tid & 63, wid = tid >> 6, r32 = lane & 31, hi = lane >> 5;
    unsigned char* R0 = lds; unsigned char* R1 = lds + 34816; unsigned char* R2 = lds + 2 * 34816; unsigned char* R3 = lds + 3 * 34816;
    float* dtv = (float*)(lds + 4 * 34816); float* acum = dtv + 256; float* wsc = acum + 256; float* tot = wsc + 256; float* rstd = tot + 8;
    float* YB = (float*)lds;
    const bf16* PROJ = (const bf16*)(P.ws + WS_PROJ); bf16* MIX = (bf16*)(P.ws + WS_MIX);
    const float* DT = (const float*)(P.ws + WS_DT); float* ST = (float*)(P.ws + WS_ST); float* CD = (float*)(P.ws + WS_CDEC);
    const bf16* CONVB = (const bf16*)(P.ws + WS_CONV);
    for (int item = blockIdx.x; item < 512; item += gridDim.x) {
        const int g = item & 1, c = (item >> 1) & 63, b = item >> 7, t0 = c * 128; const unsigned rowb = (unsigned)b * SEQ;
        int tv = tid; asm volatile("" : "+v"(tv));
        __syncthreads();
        if (tid < 256) { const int s = tid & 127, hl = tid >> 7, hh = 2 * g + hl;
            const float dt = softplusf(DT[(rowb + t0 + s) * 4 + hh] + P.in[I_SDTB][layer * 4 + hh]); float v = dt * -expf(P.in[I_SALOG][layer * 4 + hh]);
#pragma unroll
            for (int o = 1; o < 64; o <<= 1) { const float u = __shfl_up(v, o); if (lane >= o) v += u; }
            dtv[tid] = dt; acum[tid] = v; if (lane == 63) tot[wid] = v; }
        __syncthreads();
        if (tid < 256 && (tid & 64)) acum[tid] += tot[wid - 1];
        __syncthreads();
        if (pass == 0) { if (tid < 256) wsc[tid] = dtv[tid] * __expf(acum[(tid & 128) + 127] - acum[tid]); __syncthreads(); }
        { constexpr int NCH = pass == 0 ? 8 : 12;
#pragma unroll
          for (int i = 0; i < NCH; ++i) { const int idx = tv + NT * i, tile = idx >> 11, row = (idx >> 4) & 127, c16 = idx & 15;
              bf16x8 v = *(const bf16x8*)(CONVB + ((rowb + t0 + row) * DM + 256 + 256 * tile + g * 128 + 8 * c16));
              if (pass == 0 && tile == 0) { const float sc = wsc[(c16 >> 3) * 128 + row]; float o[8];
#pragma unroll
                  for (int e = 0; e < 8; ++e) o[e] = bf2f((bf16)v[e]) * sc;
                  v = pack8f(o); }
              unsigned char* dst = (tile == 0 ? (pass == 0 ? R0 : R2) : (tile == 1 ? R1 : R0));
              *(bf16x8*)(dst + row * 272 + c16 * 16) = v; } }
        const int mt = wid >> 1, nt0 = 2 * (wid & 1);
        if (pass == 0) {
            __syncthreads();
            f32x16 acc[2]; acc[0] = f32x16{}; acc[1] = f32x16{};
#pragma unroll
            for (int ks = 0; ks < 8; ++ks) { const bf16x8 a = trfrag(R0, ks, mt, lane); acc[0] = mfma32(a, trfrag(R1, ks, nt0, lane), acc[0]); acc[1] = mfma32(a, trfrag(R1, ks, nt0 + 1, lane), acc[1]); }
#pragma unroll
            for (int j = 0; j < 2; ++j)
#pragma unroll
                for (int r = 0; r < 16; ++r) { const int pl = 32 * mt + crow(r, hi), hh = 2 * g + (pl >> 6); ST[(unsigned)(((b * 64 + c) * 4 + hh) * 8192 + (pl & 63) * 128 + 32 * (nt0 + j) + r32)] = acc[j][r]; }
            if (tid < 2) CD[(b * 64 + c) * 4 + 2 * g + tid] = __expf(acum[tid * 128 + 127]);
        } else {
#pragma unroll
            for (int i = 0; i < 8; ++i) { const int idx = tv + NT * i, pl = idx >> 5, n4 = (idx & 31) * 4;
                const f32x4 v = *(const f32x4*)(ST + (unsigned)(((b * 64 + c) * 4 + 2 * g + (pl >> 6)) * 8192 + (pl & 63) * 128 + n4));
                u32x2 w; w.x = pk2(v.x, v.y); w.y = pk2(v.z, v.w); *(u32x2*)(R3 + pl * 272 + n4 * 2) = w; }
            __syncthreads();
            f32x16 cbt[2], ya[2]; cbt[0] = f32x16{}; cbt[1] = f32x16{}; ya[0] = f32x16{}; ya[1] = f32x16{};
#pragma unroll 2
            for (int ks = 0; ks < 8; ++ks) { const int ko = (16 * ks + 8 * hi) * 2; const bf16x8 a = *(const bf16x8*)(R0 + (32 * mt + r32) * 272 + ko);
                cbt[0] = mfma32(a, *(const bf16x8*)(R1 + (32 * nt0 + r32) * 272 + ko), cbt[0]);
                cbt[1] = mfma32(a, *(const bf16x8*)(R1 + (32 * (nt0 + 1) + r32) * 272 + ko), cbt[1]);
                ya[0] = mfma32(a, *(const bf16x8*)(R3 + (32 * (wid & 1) + r32) * 272 + ko), ya[0]);
                ya[1] = mfma32(a, *(const bf16x8*)(R3 + (64 + 32 * (wid & 1) + r32) * 272 + ko), ya[1]); }
#pragma unroll
            for (int hl = 0; hl < 2; ++hl)
#pragma unroll
                for (int r = 0; r < 16; ++r) ya[hl][r] *= __expf(acum[hl * 128 + 32 * mt + crow(r, hi)]);
            __syncthreads();
#pragma unroll
            for (int hl = 0; hl < 2; ++hl) { unsigned char* dstm = hl ? R0 : R1;
#pragma unroll
                for (int j = 0; j < 2; ++j) { const int s = 32 * (nt0 + j) + r32; const float as = acum[hl * 128 + s], ds = dtv[hl * 128 + s];
#pragma unroll
                    for (int r = 0; r < 16; ++r) { const int lrow = 32 * mt + crow(r, hi);
                        const float v = (s <= lrow) ? cbt[j][r] * __expf(fminf(acum[hl * 128 + lrow] - as, 0.f)) * ds : 0.f; *(bf16*)(dstm + lrow * 272 + s * 2) = (bf16)f2bf(v); } } }
            __syncthreads();
#pragma unroll
            for (int hl = 0; hl < 2; ++hl) { const unsigned char* Mh = (hl ? R0 : R1) + (32 * mt + r32) * 272 + 8 * hi; const int pt = 2 * hl + (wid & 1);
#pragma unroll 2
                for (int ks = 0; ks < 8; ++ks) { const s16x4 lo = *(const s16x4*)(Mh + 32 * ks), h4 = *(const s16x4*)(Mh + 32 * ks + 16);
                    ya[hl] = mfma32((bf16x8){lo[0], lo[1], lo[2], lo[3], h4[0], h4[1], h4[2], h4[3]}, trfrag(R2, ks, pt, lane), ya[hl]); } }
#pragma unroll
            for (int hl = 0; hl < 2; ++hl) { const int hh = 2 * g + hl, pl = 64 * hl + 32 * (wid & 1) + r32; const float dsk = P.in[I_SD][layer * 4 + hh];
#pragma unroll
                for (int r = 0; r < 16; ++r) { const int lrow = 32 * mt + crow(r, hi); const float xv = bf2f(*(const bf16*)(R2 + lrow * 272 + pl * 2));
                    const float z = bf2f(PROJ[(rowb + t0 + lrow) * NPROJ + PC_Z + hh * 64 + (pl & 63)]); ya[hl][r] = (ya[hl][r] + dsk * xv) * (z * sigm(z)); } }
            __syncthreads();
#pragma unroll
            for (int hl = 0; hl < 2; ++hl) { const int pl = 64 * hl + 32 * (wid & 1) + r32;
#pragma unroll
                for (int r = 0; r < 16; ++r) YB[(32 * mt + crow(r, hi)) * 132 + pl] = ya[hl][r]; }
            __syncthreads();
            { const int lrow = tv >> 2, q = tv & 3; const float* yr = YB + lrow * 132 + q; float ss = 0.f;
#pragma unroll
              for (int e = 0; e < 32; ++e) ss += yr[4 * e] * yr[4 * e];
              ss += __shfl_xor(ss, 1); ss += __shfl_xor(ss, 2);
              if (q == 0) rstd[lrow] = 1.0f / sqrtf(ss * (1.0f / 128.0f) + EPS); }
            __syncthreads();
#pragma unroll
            for (int i = 0; i < 4; ++i) { const int idx = tv + NT * i, lrow = idx >> 4, cn = idx & 15; const float rs = rstd[lrow];
                const f32x4 y0 = *(const f32x4*)(YB + lrow * 132 + 8 * cn), y1 = *(const f32x4*)(YB + lrow * 132 + 8 * cn + 4);
                const float* gn = P.in[I_SNORM] + layer * 256 + g * 128 + 8 * cn; const f32x4 g0 = *(const f32x4*)gn, g1 = *(const f32x4*)(gn + 4);
                u32x4 w; w.x = pk2(y0.x * rs * g0.x, y0.y * rs * g0.y); w.y = pk2(y0.z * rs * g0.z, y0.w * rs * g0.w); w.z = pk2(y1.x * rs * g1.x, y1.y * rs * g1.y); w.w = pk2(y1.z * rs * g1.z, y1.w * rs * g1.w);
                *(u32x4*)(MIX + (rowb + t0 + lrow) * DM + MX_C + g * 128 + 8 * cn) = w; }
        }
    }
}
__device__ __forceinline__ void ph_scan(const Params& P) {
    float* ST = (float*)(P.ws + WS_ST); const float* CD = (const float*)(P.ws + WS_CDEC);
    const int gid = blockIdx.x * NT + mk_tid();
    for (int e = gid; e < BATCH * 4 * 8192; e += gridDim.x * NT) {
        const int b = e >> 15, hh = (e >> 13) & 3, pn = e & 8191; float carry = 0.f;
#pragma unroll 1
        for (int c0 = 0; c0 < 64; c0 += 8) { float st[8], cd[8];
#pragma unroll
            for (int i = 0; i < 8; ++i) { st[i] = ST[((size_t)((b * 64 + c0 + i) * 4 + hh)) * 8192 + pn]; cd[i] = CD[(b * 64 + c0 + i) * 4 + hh]; }
#pragma unroll
            for (int i = 0; i < 8; ++i) { ST[((size_t)((b * 64 + c0 + i) * 4 + hh)) * 8192 + pn] = carry; carry = carry * cd[i] + st[i]; } }
    }
    const float* LSUM = (const float*)(P.ws + WS_LSUM); float* LCAR = (float*)(P.ws + WS_LSUM + 524288);
    if (gid < BATCH * 256) { const int b = gid >> 8, ch = gid & 255; float carry = 0.f;
#pragma unroll 1
        for (int c0 = 0; c0 < 64; c0 += 8) { float a[8], h[8];
#pragma unroll
            for (int i = 0; i < 8; ++i) { a[i] = LSUM[(size_t)(b * 64 + c0 + i) * 512 + ch]; h[i] = LSUM[(size_t)(b * 64 + c0 + i) * 512 + 256 + ch]; }
#pragma unroll
            for (int i = 0; i < 8; ++i) { LCAR[(size_t)(b * 64 + c0 + i) * 256 + ch] = carry; carry = a[i] * carry + h[i]; } }
    }
}

#define LAS __attribute__((address_space(3)))
#define XB_TMO      128
#define XB_XCNT(j)  (256  + 64 * (j))
#define XB_XSUB(j)  (1280 + 64 * (j))
#define XB_XGEN(j)  (2304 + 64 * (j))
#define XB_TOP      3328
#define XB_TOPGEN   3392
#define XCD_BAR_WORDS 3456
#define XB_SPIN_CAP (1u << 18)

__device__ __forceinline__ unsigned xb_ld(unsigned* p)              { return __hip_atomic_load(p, __ATOMIC_RELAXED, __HIP_MEMORY_SCOPE_AGENT); }
__device__ __forceinline__ unsigned xb_add(unsigned* p, unsigned v) { return __hip_atomic_fetch_add(p, v, __ATOMIC_RELAXED, __HIP_MEMORY_SCOPE_AGENT); }
__device__ __forceinline__ unsigned xb_xcc_id() { return (unsigned)__builtin_amdgcn_s_getreg((3 << 11) | 20) & 0xFu; }
#define XB_SPIN(cond, bar) do { unsigned _sp = 0; while (cond) { __builtin_amdgcn_s_sleep(1); \
    if ((++_sp & 255u) == 0u) { if (xb_ld(&(bar)[XB_TMO])) break; if (_sp > XB_SPIN_CAP) { atomicAdd(&(bar)[XB_TMO], 1u); break; } } } } while (0)

struct XcdBarrier {
    unsigned* bar; unsigned x;
    volatile LAS unsigned* st;
};

__device__ __forceinline__ XcdBarrier xcd_barrier_post(unsigned* bar, volatile LAS unsigned* st) {
    XcdBarrier b; b.bar = bar; b.x = xb_xcc_id(); b.st = st;
    if (threadIdx.x == 0) (void)xb_add(&bar[XB_XCNT(b.x)], 1u);
    return b;
}
__device__ __forceinline__ void xcd_barrier_complete(unsigned* bar, unsigned x, unsigned& nloc, unsigned& nx) {
    const unsigned G = gridDim.x * gridDim.y * gridDim.z;
    unsigned sum, cnt, mine, sp = 0u;
    for (;;) {
        sum = 0u; cnt = 0u; mine = 0u;
#pragma unroll
        for (unsigned j = 0; j < 16; ++j) { const unsigned c = xb_ld(&bar[XB_XCNT(j)]); sum += c; cnt += (c > 0u) ? 1u : 0u; mine = (j == x) ? c : mine; }
        if (sum == G) break;
        __builtin_amdgcn_s_sleep(1);
        if ((++sp & 255u) == 0u) { if (xb_ld(&bar[XB_TMO])) break; if (sp > XB_SPIN_CAP) { atomicAdd(&bar[XB_TMO], 1u); break; } }
    }
    nloc = mine > 0u ? mine : 1u; nx = cnt > 0u ? cnt : 1u;
}

__device__ __forceinline__ void xcd_barrier(const XcdBarrier& b) {
    asm volatile("s_waitcnt vmcnt(0)" ::: "memory");
    __syncthreads();
    if (threadIdx.x == 0) {
        unsigned* bar = b.bar;
        __builtin_amdgcn_s_waitcnt(0);
        unsigned nloc = b.st[0], nx = b.st[1];
        if (nloc == 0u) { xcd_barrier_complete(bar, b.x, nloc, nx); b.st[0] = nloc; b.st[1] = nx; }
        const unsigned old = xb_add(&bar[XB_XSUB(b.x)], 1u);
        const unsigned gen = old / nloc;
        if (old + 1u == (gen + 1u) * nloc) {
            __builtin_amdgcn_fence(__ATOMIC_RELEASE, "agent");
            asm volatile("s_waitcnt vmcnt(0)" ::: "memory");
            const unsigned og = xb_add(&bar[XB_TOP], 1u);
            const unsigned tg = og / nx;
            if (og + 1u == (tg + 1u) * nx) xb_add(&bar[XB_TOPGEN], 1u);
            else XB_SPIN(xb_ld(&bar[XB_TOPGEN]) == tg, bar);
            __builtin_amdgcn_fence(__ATOMIC_ACQUIRE, "agent");
            xb_add(&bar[XB_XGEN(b.x)], 1u);
            asm volatile("s_waitcnt vmcnt(0)" ::: "memory");
        } else {
            XB_SPIN(xb_ld(&bar[XB_XGEN(b.x)]) == gen, bar);
            __builtin_amdgcn_fence(__ATOMIC_ACQUIRE, "agent");
            asm volatile("s_waitcnt vmcnt(0)" ::: "memory");
        }
    }
    __syncthreads();
}

constexpr int NPH = 1 + 10 * DEPTH;
#ifndef MK_REP_DIFF
#define MK_REP_DIFF 1
#endif
#ifndef MK_REP_DIL
#define MK_REP_DIL 1
#endif
#ifndef MK_REP_BC1
#define MK_REP_BC1 1
#endif
#ifndef MK_REP_BC0
#define MK_REP_BC0 1
#endif
#ifndef MK_EXTRA_SYNC
#define MK_EXTRA_SYNC 0
#endif
__global__ void __launch_bounds__(NT, 2) mega(Params P, int ph_lo, int ph_hi) {
    extern __shared__ __attribute__((aligned(16))) unsigned char lds[];
    cooperative_groups::grid_group grid = cooperative_groups::this_grid();
    unsigned char* ws = P.ws;
    volatile LAS unsigned* bst = (volatile LAS unsigned*)((LAS unsigned char*)lds + (LDS_BYTES - 64));
    if (threadIdx.x < 16) bst[threadIdx.x] = 0u;
    __syncthreads();
    XcdBarrier bar = xcd_barrier_post((unsigned*)(ws + WS_CTL) + 4096, bst);
    bf16* XN = (bf16*)(ws + WS_XN); bf16* PROJ = (bf16*)(ws + WS_PROJ); bf16* MIX = (bf16*)(ws + WS_MIX); bf16* HID = (bf16*)(ws + WS_HID);
    float* Y1 = (float*)(ws + WS_Y1); float* Y2 = (float*)(ws + WS_Y2); float* DT = (float*)(ws + WS_DT);
#define MK_PH(k) (ph_lo <= (k) && (k) < ph_hi)
#define MK_SEAM(k) do { if ((k) + 1 < ph_hi) { if ((k) == 0) grid.sync(); else xcd_barrier(bar); } } while (0)
    if (MK_PH(0)) {
        ph_prep(P, lds);
        ph_row(nullptr, nullptr, P.in[I_X], nullptr, P.in[I_NMPRE], XN, P.in[I_WIN] + 2304, DT);
        MK_SEAM(0);
    }
#pragma unroll 1
    for (int layer = 0; layer < DEPTH; ++layer) {
        const int pb = 1 + 10 * layer;
        const bf16* wl = (const bf16*)(ws + WS_W + (size_t)layer * W_LAYER);
        const float* hin = layer == 0 ? P.in[I_X] : P.out;
        if (MK_PH(pb + 0)) { pg8::Gemm g{XN, wl + WO_IN / 2, MROWS, NPROJ, DM, 0}; pg8::EpiBf16R<0> e{PROJ, NPROJ, 0}; ph_gemm(g, e, lds); MK_SEAM(pb + 0); }
        if (MK_PH(pb + 1)) {
            ph_conv(P, layer);
#pragma unroll 1
            for (int rep = 0; rep < MK_REP_DIL; ++rep) { ph_dilated(P, lds); __syncthreads(); }
            MK_SEAM(pb + 1); }
        if (MK_PH(pb + 2)) {
#pragma unroll 1
            for (int rep = 0; rep < MK_REP_BC0; ++rep) { ph_lru<0>(P, layer); __syncthreads(); ph_ssd<0>(P, layer, lds); __syncthreads(); }
            MK_SEAM(pb + 2); }
        if (MK_PH(pb + 3)) { ph_scan(P); MK_SEAM(pb + 3);
#pragma unroll 1
            for (int rep = 0; rep < MK_EXTRA_SYNC; ++rep) xcd_barrier(bar); }
        if (MK_PH(pb + 4)) {
#pragma unroll 1
            for (int rep = 0; rep < MK_REP_DIFF; ++rep) { ph_diff(P, layer, lds); __syncthreads(); }
#pragma unroll 1
            for (int rep = 0; rep < MK_REP_BC1; ++rep) { ph_lru<1>(P, layer); __syncthreads(); ph_ssd<1>(P, layer, lds); __syncthreads(); }
            MK_SEAM(pb + 4); }
        if (MK_PH(pb + 5)) { pg8::Gemm g{MIX, wl + WO_OUT / 2, MROWS, DM, DM, 0}; pg8::EpiF32 e{Y1, DM, 0}; ph_gemm(g, e, lds); MK_SEAM(pb + 5); }
        if (MK_PH(pb + 6)) { ph_row(Y1, P.in[I_NMPOST] + layer * DM, hin, P.out, P.in[I_NFPRE] + layer * DM, XN, nullptr, nullptr); MK_SEAM(pb + 6); }
        if (MK_PH(pb + 7)) { pg8::Gemm g{XN, wl + WO_UP / 2, MROWS, DFF, DM, 0}; pg8::EpiBf16R<2> e{HID, DFF, 0}; ph_gemm(g, e, lds); MK_SEAM(pb + 7); }
        if (MK_PH(pb + 8)) { pg8::Gemm g{HID, wl + WO_DOWN / 2, MROWS, DM, DFF, 0}; pg8::EpiF32 e{Y2, DM, 0}; ph_gemm(g, e, lds); MK_SEAM(pb + 8); }
        if (MK_PH(pb + 9)) { const bool last = layer == DEPTH - 1;
            ph_row(Y2, P.in[I_NFPOST] + layer * DM, P.out, P.out, last ? nullptr : P.in[I_NMPRE] + (layer + 1) * DM, XN, last ? nullptr : P.in[I_WIN] + (size_t)(layer + 1) * DM * PIN + 2304, DT);
            MK_SEAM(pb + 9); }
    }
}
}

#ifndef MK_N_LAUNCHES
#define MK_N_LAUNCHES 1
#endif
extern "C" void kernel_launch(void* const* d_in, const int* in_sizes, int n_in, void* d_out, int out_size, void* d_ws, size_t ws_size, hipStream_t stream) {
    using namespace mk;
    static int grid = 0;
    if (grid == 0) {
        if (n_in != N_IN || in_sizes[0] != MROWS * DM || out_size != MROWS * DM || ws_size < WS_END) {
            fprintf(stderr, "kernel_launch: unexpected shapes: n_in %d in0 %d out %d ws %zu (need %zu)\n", n_in, n_in > 0 ? in_sizes[0] : -1, out_size, ws_size, (size_t)WS_END); grid = -1; return; }
        (void)hipFuncSetAttribute((const void*)mega, hipFuncAttributeMaxDynamicSharedMemorySize, LDS_BYTES);
        int dev = 0, cus = 0, per_cu = 0;
        (void)hipGetDevice(&dev);
        (void)hipDeviceGetAttribute(&cus, hipDeviceAttributeMultiprocessorCount, dev);
        (void)hipOccupancyMaxActiveBlocksPerMultiprocessor(&per_cu, (const void*)mega, NT, LDS_BYTES);
        (void)hipGetLastError();
        if (per_cu < 1 || cus < 1) { fprintf(stderr, "kernel_launch: occupancy query: %d blocks/CU, %d CUs\n", per_cu, cus); grid = -1; return; }
        grid = cus;
    }
    if (grid < 0) return;
    Params P{};
    for (int i = 0; i < N_IN; ++i) P.in[i] = (const float*)d_in[i];
    P.out = (float*)d_out; P.ws = (unsigned char*)d_ws;
#if MK_N_LAUNCHES == 1
    (void)hipMemsetAsync((unsigned char*)d_ws + WS_CTL, 0, 65536, stream);
    int lo = 0, hi = NPH;
    void* args[] = {(void*)&P, (void*)&lo, (void*)&hi};
    hipError_t e = hipLaunchCooperativeKernel((const void*)mega, dim3(grid), dim3(NT), args, LDS_BYTES, stream);
    if (e != hipSuccess) fprintf(stderr, "kernel_launch: cooperative launch failed: %s (grid %d)\n", hipGetErrorString(e), grid);
#else
    for (int p = 0; p < NPH; ++p) hipLaunchKernelGGL(mega, dim3(grid), dim3(NT), LDS_BYTES, stream, P, p, p + 1);
#endif
}
```

```cpp
#include <hip/hip_runtime.h>
#include <cstdio>
#include <cstdint>
#include <cmath>
#include <hip/hip_cooperative_groups.h>
__device__ __forceinline__ int mk_tid() { int t = (int)threadIdx.x; asm volatile("" : "+v"(t)); return t; }
namespace pg8 {
#define PG8_LAS __attribute__((address_space(3)))
typedef unsigned short bf16_t;
typedef short bf16x8 __attribute__((ext_vector_type(8)));
typedef float f32x4 __attribute__((ext_vector_type(4)));
typedef unsigned u32x4 __attribute__((ext_vector_type(4)));
constexpr int BM = 256, BK = 64, HALF = 128, HTB = HALF * BK * 2  , STAGE_BYTES = 8 * HTB, NXCD = 8, WGM = 8;

__host__ __device__ __forceinline__ int lds_byte(int r, int c) { const int st = (r >> 4) * 2 + (c >> 5), rr = r & 15, cc = c & 31, ob = rr * 64 + cc * 2; return st * 1024 + (ob ^ (((ob >> 9) & 1) << 5)); }
__host__ __device__ __forceinline__ void stage_rc(int b, int& R, int& C) { const int st = b / 1024, sb = b % 1024, swz = sb ^ (((sb >> 9) & 1) << 5); R = (st >> 1) * 16 + swz / 64; C = (st & 1) * 32 + (swz % 64) / 2; }
__host__ __device__ __forceinline__ int perm32(int rho) { const int n = rho >> 4, i = rho & 15; return 8 * (i >> 2) + 4 * n + (i & 3); }

struct Unit { int pm, pn; };
struct Gemm { const bf16_t* A; const bf16_t* Bt; int M, N, K, pad; };

struct StaticOrder {
    int nM, nN, nwg, G, c;
    __host__ __device__ void init(int M, int N, int G_, int c_) { nM = M / BM; nN = N / BM; nwg = nM * nN; G = G_; c = c_; }
    __host__ __device__ bool next(int i, Unit& u) const {
        const long L = (long)i * G + c; if (L >= nwg) return false;
        int wgid = (int)L; { const int q = nwg / NXCD, r = nwg % NXCD, xcd = wgid % NXCD, off = wgid / NXCD; wgid = (xcd < r ? xcd * (q + 1) : r * (q + 1) + (xcd - r) * q) + off; }
        const int nig = WGM * nN, gid = wgid / nig, fm = gid * WGM, gsz = (nM - fm) < WGM ? (nM - fm) : WGM;
        u.pm = fm + ((wgid % nig) % gsz); u.pn = (wgid % nig) / gsz; return true;
    }
    __device__ __forceinline__ void a_ready(const Unit&) const {}
    __device__ __forceinline__ void done(const Unit&) const {}
};

__device__ __forceinline__ unsigned cvt_pk_bf16(float lo, float hi) { unsigned r; asm volatile("v_cvt_pk_bf16_f32 %0, %1, %2" : "=v"(r) : "v"(lo), "v"(hi)); return r; }
typedef float f32x2 __attribute__((ext_vector_type(2)));
__device__ __forceinline__ f32x2 gelu_pk(f32x2 v) {
    const f32x2 av = __builtin_elementwise_abs(v), d = av * 0.2316418882f + 1.0f;
    f32x2 t; t.x = __builtin_amdgcn_rcpf(d.x); t.y = __builtin_amdgcn_rcpf(d.y);
    f32x2 q = t * 0.5307027145f + (-0.7265760135f); q = q * t + 0.7107068705f; q = q * t + (-0.142248368f); q = q * t + 0.127414796f; q = q * t;
    const f32x2 s = (v * v) * (-0.72134752044f);
    f32x2 e; e.x = __builtin_amdgcn_exp2f(s.x); e.y = __builtin_amdgcn_exp2f(s.y);
    const f32x2 m = v * (q * e), r = v - m;
    f32x2 o; o.x = v.x < 0.f ? m.x : r.x; o.y = v.y < 0.f ? m.y : r.y; return o;
}

template <int ACT  > struct EpiBf16 {
    static constexpr bool PERM = true, AFTER_DRAIN = false; static_assert(ACT == 0 || ACT == 1, "EpiBf16: ACT is 0 (none) or 1 (gelu_pk)");
    bf16_t* O; int ldc; const float* bias; int split_cols; size_t split_stride; float scale0;
    __device__ __forceinline__ void operator()(const f32x4 (&acc)[2][2][4][2], const Unit& u, int wr, int wc, int fr, int fq) const {
        const int row0 = u.pm * BM + wr * 64 + fr; int colt = u.pn * BM; bf16_t* base = O;
        float sc = 1.f; if (split_cols) { const int t = colt / split_cols; base += (size_t)t * split_stride; colt -= t * split_cols; if (t == 0) sc = scale0; }
        const int col0 = colt + wc * 32 + 8 * fq, bcol0 = u.pn * BM + wc * 32 + 8 * fq;
        f32x4 bv[2][2];
#pragma unroll
        for (int bj = 0; bj < 2; ++bj)
#pragma unroll
            for (int n = 0; n < 2; ++n) bv[bj][n] = bias ? *(const f32x4*)(bias + bcol0 + bj * HALF + 4 * n) : (f32x4){0.f, 0.f, 0.f, 0.f};
#pragma unroll
        for (int ai = 0; ai < 2; ++ai)
#pragma unroll
            for (int m = 0; m < 4; ++m) { bf16_t* rowp = base + (size_t)(row0 + ai * HALF + m * 16) * ldc + col0;
#pragma unroll
                for (int bj = 0; bj < 2; ++bj) { f32x4 v0 = acc[ai][bj][m][0] + bv[bj][0], v1 = acc[ai][bj][m][1] + bv[bj][1];
                    if (ACT == 1) { f32x2 a = gelu_pk((f32x2){v0[0], v0[1]}), b = gelu_pk((f32x2){v0[2], v0[3]}), c = gelu_pk((f32x2){v1[0], v1[1]}), d = gelu_pk((f32x2){v1[2], v1[3]});
                        v0 = (f32x4){a.x, a.y, b.x, b.y}; v1 = (f32x4){c.x, c.y, d.x, d.y}; }
                    v0 = v0 * sc; v1 = v1 * sc; u32x4 w; w.x = cvt_pk_bf16(v0[0], v0[1]); w.y = cvt_pk_bf16(v0[2], v0[3]); w.z = cvt_pk_bf16(v1[0], v1[1]); w.w = cvt_pk_bf16(v1[2], v1[3]);
                    *(u32x4*)(rowp + bj * HALF) = w; } }
    }
};

struct PanelStats {
    unsigned* xbuf;
    unsigned* cnt;
    unsigned* tmo;
    int ntn; float eps;
    unsigned code;
    __device__ __forceinline__ bool run(const f32x4 (&v)[2][2][4][2], const Unit& u, int wr, int wc, int fr, int fq, PG8_LAS unsigned char* lds, int wid, int lane) const {
        typedef float f32x2v __attribute__((ext_vector_type(2)));
        PG8_LAS f32x2v* P = (PG8_LAS f32x2v*)lds;
        PG8_LAS f32x2v* S = (PG8_LAS f32x2v*)(lds + 8192);
        PG8_LAS unsigned* flag = (PG8_LAS unsigned*)(lds + 8192 + 2048);
#pragma unroll
        for (int ai = 0; ai < 2; ++ai)
#pragma unroll
            for (int m = 0; m < 4; ++m) {
                float s = 0.f;
#pragma unroll
                for (int bj = 0; bj < 2; ++bj)
#pragma unroll
                    for (int n = 0; n < 2; ++n) { const f32x4 x = v[ai][bj][m][n]; s += (x[0] + x[1]) + (x[2] + x[3]); }
                s += __shfl_xor(s, 16); s += __shfl_xor(s, 32);
                const float mw = s * (1.0f / 64.0f); float q = 0.f;
#pragma unroll
                for (int bj = 0; bj < 2; ++bj)
#pragma unroll
                    for (int n = 0; n < 2; ++n) { const f32x4 d = v[ai][bj][m][n] - mw; q += (d[0] * d[0] + d[1] * d[1]) + (d[2] * d[2] + d[3] * d[3]); }
                q += __shfl_xor(q, 16); q += __shfl_xor(q, 32);
                if (fq == 0) P[(ai * HALF + wr * 64 + m * 16 + fr) * 4 + wc] = (f32x2v){mw, q};
            }
        asm volatile("s_waitcnt lgkmcnt(0)" ::: "memory"); __builtin_amdgcn_s_barrier(); asm volatile("" ::: "memory");
#if defined(BROKEN_EXCHANGE_NO_WAIT)
#warning BROKEN CONTROL BUILD: the row-statistics exchange does not wait; results are wrong by design
        if (blockIdx.x >= 64) { const long long t0_ = clock64(); while (clock64() - t0_ < 60000) __builtin_amdgcn_s_sleep(8); }
#endif
        const int row = wid * 32 + (lane & 31);
        if (lane < 32) {
            const f32x2v a = P[row * 4 + 0], b = P[row * 4 + 1], c = P[row * 4 + 2], d = P[row * 4 + 3];
            const float mt = (a.x + b.x + c.x + d.x) * 0.25f;
            const float da = a.x - mt, db = b.x - mt, dc = c.x - mt, dd = d.x - mt;
            const float m2 = (a.y + b.y) + (c.y + d.y) + 64.0f * ((da * da + db * db) + (dc * dc + dd * dd));
            unsigned long long* slot = (unsigned long long*)xbuf + ((size_t)(u.pm * BM + row) * 4 + u.pn);
            __hip_atomic_store(slot, ((unsigned long long)__float_as_uint(m2) << 32) | __float_as_uint(mt), __ATOMIC_RELAXED, __HIP_MEMORY_SCOPE_AGENT);
        }
        asm volatile("s_waitcnt vmcnt(0)" ::: "memory");
        if (lane == 0) __hip_atomic_fetch_add(cnt + 64 * u.pm, 1u, __ATOMIC_RELAXED, __HIP_MEMORY_SCOPE_AGENT);
        if (wid == 0) {
            bool dead = false; const unsigned long long t0 = __builtin_amdgcn_s_memrealtime(); const unsigned want = 8u * (unsigned)ntn;
            for (;;) {
#if defined(BROKEN_EXCHANGE_NO_WAIT)
                break;
#endif
                if ((unsigned)__builtin_amdgcn_readfirstlane(__hip_atomic_load(cnt + 64 * u.pm, __ATOMIC_RELAXED, __HIP_MEMORY_SCOPE_AGENT)) >= want) break;
                if (__builtin_amdgcn_s_memrealtime() - t0 > 2000000ull) {
                    if (lane == 0) { unsigned expect = 0u; __hip_atomic_compare_exchange_strong(tmo + 1, &expect, code | (unsigned)(u.pm & 0xff), __ATOMIC_RELAXED, __ATOMIC_RELAXED, __HIP_MEMORY_SCOPE_AGENT);
                                     __hip_atomic_store(tmo, 1u, __ATOMIC_RELAXED, __HIP_MEMORY_SCOPE_AGENT); }
                    dead = true; break; }
                __builtin_amdgcn_s_sleep(2);
            }
            __builtin_amdgcn_fence(__ATOMIC_ACQUIRE, "agent");
            if (lane == 0) flag[0] = dead ? 1u : 0u;
        }
        asm volatile("s_waitcnt vmcnt(0) lgkmcnt(0)" ::: "memory"); __builtin_amdgcn_s_barrier(); asm volatile("" ::: "memory");
        const bool bad = flag[0] != 0u;
        if (lane < 32) {
            const unsigned long long* slot = (const unsigned long long*)xbuf + (size_t)(u.pm * BM + row) * 4; float mt[4], m2[4]; float ms = 0.f;
#pragma unroll
            for (int t = 0; t < 4; ++t) { if (t < ntn) { const unsigned long long w = __hip_atomic_load(slot + t, __ATOMIC_RELAXED, __HIP_MEMORY_SCOPE_AGENT); mt[t] = __uint_as_float((unsigned)w); m2[t] = __uint_as_float((unsigned)(w >> 32)); } else { mt[t] = 0.f; m2[t] = 0.f; } ms += mt[t]; }
            const float mean = ms / (float)ntn; float q = 0.f;
#pragma unroll
            for (int t = 0; t < 4; ++t) if (t < ntn) { const float dm = mt[t] - mean; q += m2[t] + 256.0f * dm * dm; }
            S[row] = (f32x2v){mean, 1.0f / sqrtf(q / (256.0f * (float)ntn) + eps)};
        }
        asm volatile("s_waitcnt lgkmcnt(0)" ::: "memory"); __builtin_amdgcn_s_barrier(); asm volatile("" ::: "memory");
        return bad;
    }
};
struct EpiLnRes {
    static constexpr bool PERM = false, AFTER_DRAIN = true;
    const float* base; float* out; int ldc; const float* bias; PanelStats st; unsigned poison;
    __device__ __forceinline__ void fused(f32x4 (&acc)[2][2][4][2], const Unit& u, int wr, int wc, int fr, int fq, PG8_LAS unsigned char* lds, int wid, int lane) const {
        typedef float f32x2v __attribute__((ext_vector_type(2)));
        const PG8_LAS f32x2v* S = (const PG8_LAS f32x2v*)(lds + 8192);
        const int col0 = u.pn * BM + wc * 32 + 4 * fq;
#pragma unroll
        for (int bj = 0; bj < 2; ++bj)
#pragma unroll
            for (int n = 0; n < 2; ++n) { const f32x4 bv = bias ? *(const f32x4*)(bias + col0 + bj * HALF + n * 16) : (f32x4){0.f, 0.f, 0.f, 0.f};
#pragma unroll
                for (int ai = 0; ai < 2; ++ai)
#pragma unroll
                    for (int m = 0; m < 4; ++m) acc[ai][bj][m][n] += bv; }
        f32x4 pre[4][2][2];
#pragma unroll
        for (int m = 0; m < 4; ++m) { const size_t off = (size_t)(u.pm * BM + wr * 64 + m * 16 + fr) * ldc + col0;
#pragma unroll
            for (int bj = 0; bj < 2; ++bj)
#pragma unroll
                for (int n = 0; n < 2; ++n) pre[m][bj][n] = *(const f32x4*)(base + off + bj * HALF + n * 16); }
        const bool bad = st.run(acc, u, wr, wc, fr, fq, lds, wid, lane) || poison != 0u;
        const float qnan = __builtin_nanf("");
#pragma unroll
        for (int ai = 0; ai < 2; ++ai)
#pragma unroll
            for (int m = 0; m < 4; ++m) { const int r = ai * HALF + wr * 64 + m * 16 + fr; const f32x2v sr = S[r]; const size_t off = (size_t)(u.pm * BM + r) * ldc + col0;
#pragma unroll
                for (int bj = 0; bj < 2; ++bj)
#pragma unroll
                    for (int n = 0; n < 2; ++n) { const f32x4 bs = ai == 0 ? pre[m][bj][n] : *(const f32x4*)(base + off + bj * HALF + n * 16); f32x4 o = bs + (acc[ai][bj][m][n] - sr.x) * sr.y;
                        if (bad) o = (f32x4){qnan, qnan, qnan, qnan}; *(f32x4*)(out + off + bj * HALF + n * 16) = o; }
                if (m & 1) asm volatile("" ::: "memory"); }
    }
};
struct EpiLnResLn {
    static constexpr bool PERM = false, AFTER_DRAIN = true;
    const float* base; float* out; bf16_t* xn; int ldc; const float* bias; PanelStats st1, st2; unsigned poison;
    __device__ __forceinline__ void fused(f32x4 (&acc)[2][2][4][2], const Unit& u, int wr, int wc, int fr, int fq, PG8_LAS unsigned char* lds, int wid, int lane) const {
        typedef float f32x2v __attribute__((ext_vector_type(2))); typedef unsigned u32x2v __attribute__((ext_vector_type(2)));
        const PG8_LAS f32x2v* S = (const PG8_LAS f32x2v*)(lds + 8192);
        const int col0 = u.pn * BM + wc * 32 + 4 * fq;
#pragma unroll
        for (int bj = 0; bj < 2; ++bj)
#pragma unroll
            for (int n = 0; n < 2; ++n) { const f32x4 bv = bias ? *(const f32x4*)(bias + col0 + bj * HALF + n * 16) : (f32x4){0.f, 0.f, 0.f, 0.f};
#pragma unroll
                for (int ai = 0; ai < 2; ++ai)
#pragma unroll
                    for (int m = 0; m < 4; ++m) acc[ai][bj][m][n] += bv; }
        bool bad = st1.run(acc, u, wr, wc, fr, fq, lds, wid, lane) || poison != 0u;
        const float qnan = __builtin_nanf("");
#pragma unroll
        for (int ai = 0; ai < 2; ++ai)
#pragma unroll
            for (int m = 0; m < 4; ++m) { const int r = ai * HALF + wr * 64 + m * 16 + fr; const f32x2v sr = S[r]; const size_t off = (size_t)(u.pm * BM + r) * ldc + col0;
#pragma unroll
                for (int bj = 0; bj < 2; ++bj)
#pragma unroll
                    for (int n = 0; n < 2; ++n) { const f32x4 bs = *(const f32x4*)(base + off + bj * HALF + n * 16); acc[ai][bj][m][n] = bs + (acc[ai][bj][m][n] - sr.x) * sr.y; }
                asm volatile("" : "+v"(acc[ai][0][m][0]), "+v"(acc[ai][0][m][1]), "+v"(acc[ai][1][m][0]), "+v"(acc[ai][1][m][1]));
                if (m & 1) asm volatile("" ::: "memory"); }
        const bool bad1 = bad;
        bad = st2.run(acc, u, wr, wc, fr, fq, lds, wid, lane) || bad;
#pragma unroll
        for (int ai = 0; ai < 2; ++ai)
#pragma unroll
            for (int m = 0; m < 4; ++m) { const int r = ai * HALF + wr * 64 + m * 16 + fr; const f32x2v sr = S[r]; const size_t off = (size_t)(u.pm * BM + r) * ldc + col0;
#pragma unroll
                for (int bj = 0; bj < 2; ++bj)
#pragma unroll
                    for (int n = 0; n < 2; ++n) { const f32x4 x1 = acc[ai][bj][m][n]; *(f32x4*)(out + off + bj * HALF + n * 16) = bad1 ? (f32x4){qnan, qnan, qnan, qnan} : x1;
                        const f32x4 o = (x1 - sr.x) * sr.y; u32x2v w; w.x = cvt_pk_bf16(o[0], o[1]); w.y = cvt_pk_bf16(o[2], o[3]);
                        if (bad) { w.x = 0x7fc07fc0u; w.y = 0x7fc07fc0u; } *(u32x2v*)(xn + off + bj * HALF + n * 16) = w; }
                asm volatile("" ::: "memory"); }
    }
};

template <class Epi, class Sched, bool ALIGN_EPI = false, bool SP2 = false>
__device__ __forceinline__ void gemm_phase(PG8_LAS unsigned char* lds, const Gemm g, const Sched& S, const Epi& E) {
    const int tid = mk_tid(), wid = __builtin_amdgcn_readfirstlane(tid >> 6), lane = tid & 63, wr = wid >> 2, wc = wid & 3, fr = lane & 15, fq = lane >> 4;
    const int K = g.K, nt = K / BK;
    unsigned voffA[2], voffB[2];
#pragma unroll
    for (int i = 0; i < 2; ++i) { int R, C; stage_rc(tid * 16 + i * 8192, R, C); const int Rb = Epi::PERM ? ((R & ~31) + perm32(R & 31)) : R;
        voffA[i] = (unsigned)(R * K + C) * 2u; voffB[i] = (unsigned)(Rb * K + C) * 2u; }
    const size_t kstep = (size_t)(BK * 2);
    const size_t hstep = (size_t)HALF * K * 2;
    const size_t tstep = 2 * hstep;
    const unsigned ldsw = (unsigned)wid * 1024u;
    const int aoff = lds_byte(wr * 64 + fr, fq * 8), boff = lds_byte(wc * 32 + fr, fq * 8);
#define PG8_SA(b, h) (((b) * 2 + (h)) * HTB)
#define PG8_SB(b, h) ((4 + (b) * 2 + (h)) * HTB)
#define PG8_STAGE(bufoff, gbase, voff) do { _Pragma("unroll") for (int _i = 0; _i < 2; ++_i) \
        __builtin_amdgcn_global_load_lds((const unsigned*)((const char*)(gbase) + (voff)[_i]), (PG8_LAS unsigned*)(lds + (bufoff) + ldsw + _i * 8192), 16, 0, 0); } while (0)
#define PG8_LDA(dst, b, h) do { _Pragma("unroll") for (int m = 0; m < 4; ++m) _Pragma("unroll") for (int k = 0; k < 2; ++k) dst[m][k] = *(const PG8_LAS bf16x8*)(lds + PG8_SA(b, h) + aoff + m * 2048 + k * 1024); } while (0)
#define PG8_LDB(dst, b, h) do { _Pragma("unroll") for (int n = 0; n < 2; ++n) _Pragma("unroll") for (int k = 0; k < 2; ++k) dst[n][k] = *(const PG8_LAS bf16x8*)(lds + PG8_SB(b, h) + boff + n * 2048 + k * 1024); } while (0)
#define PG8_MMA(ai, bj, At, Bt) do { __builtin_amdgcn_s_setprio(1); _Pragma("unroll") for (int m = 0; m < 4; ++m) _Pragma("unroll") for (int n = 0; n < 2; ++n) _Pragma("unroll") for (int k = 0; k < 2; ++k) \
        acc[ai][bj][m][n] = __builtin_amdgcn_mfma_f32_16x16x32_bf16(Bt[n][k], At[m][k], acc[ai][bj][m][n], 0, 0, 0); __builtin_amdgcn_s_setprio(0); } while (0)
#define PG8_WAIT_V(n) asm volatile("s_waitcnt vmcnt(" #n ")" ::: "memory")
#define PG8_WAIT_L(n) asm volatile("s_waitcnt lgkmcnt(" #n ")" ::: "memory")
#define PG8_BAR __builtin_amdgcn_s_barrier()
#define PG8_SCHED __builtin_amdgcn_sched_barrier(0)
    Unit cur, nxt; int ui = 0;
    if (!S.next(0, cur)) return;
    f32x4 acc[2][2][4][2];
#pragma unroll
    for (int a = 0; a < 2; ++a)
#pragma unroll
        for (int b = 0; b < 2; ++b)
#pragma unroll
            for (int m = 0; m < 4; ++m)
#pragma unroll
                for (int n = 0; n < 2; ++n) acc[a][b][m][n] = (f32x4){0.f, 0.f, 0.f, 0.f};
    bf16x8 At[4][2], B0[2][2], B1[2][2];
    const char* cA = (const char*)g.A + (size_t)cur.pm * tstep; const char* cB = (const char*)g.Bt + (size_t)cur.pn * tstep;
    S.a_ready(cur);
    if constexpr (SP2) {
        PG8_STAGE(PG8_SB(0, 0), cB, voffB); PG8_STAGE(PG8_SB(0, 1), cB + hstep, voffB); PG8_STAGE(PG8_SA(0, 0), cA, voffA); PG8_STAGE(PG8_SA(0, 1), cA + hstep, voffA);
        if (wr == 1) PG8_BAR;
        PG8_WAIT_V(2); PG8_BAR;
        PG8_STAGE(PG8_SB(1, 0), cB + kstep, voffB); PG8_STAGE(PG8_SA(1, 0), cA + kstep, voffA); PG8_STAGE(PG8_SB(1, 1), cB + hstep + kstep, voffB);
        PG8_WAIT_V(6); PG8_BAR;
    } else {
        PG8_STAGE(PG8_SB(0, 0), cB, voffB); PG8_STAGE(PG8_SA(0, 0), cA, voffA); PG8_STAGE(PG8_SB(0, 1), cB + hstep, voffB); PG8_STAGE(PG8_SA(0, 1), cA + hstep, voffA);
        if (wr == 1) PG8_BAR;
        PG8_WAIT_V(4); PG8_BAR;
        PG8_STAGE(PG8_SB(1, 0), cB + kstep, voffB); PG8_STAGE(PG8_SA(1, 0), cA + kstep, voffA); PG8_STAGE(PG8_SB(1, 1), cB + hstep + kstep, voffB);
        PG8_WAIT_V(6); PG8_BAR;
    }
    for (;;) {
        const bool has_next = S.next(ui + 1, nxt);
        const char* nA = has_next ? (const char*)g.A + (size_t)nxt.pm * tstep : cA; const char* nB = has_next ? (const char*)g.Bt + (size_t)nxt.pn * tstep : cB;
        for (int t = 0; t < nt; t += 2) {
            const bool last = (t == nt - 2);
            const char* a1 = cA + (size_t)(t + 1) * kstep;
            const char* a2 = last ? nA : cA + (size_t)(t + 2) * kstep; const char* b2 = last ? nB : cB + (size_t)(t + 2) * kstep;
            const char* a3 = a2 + kstep; const char* b3 = b2 + kstep;
            if (last && has_next) S.a_ready(nxt);
            if constexpr (SP2) {
            PG8_LDB(B0, 0, 0); PG8_LDB(B1, 0, 1); PG8_SCHED; PG8_LDA(At, 0, 0); PG8_STAGE(PG8_SA(1, 1), a1 + hstep, voffA);
            PG8_WAIT_V(8); PG8_WAIT_L(0); PG8_BAR; PG8_MMA(0, 0, At, B0); PG8_MMA(0, 1, At, B1); PG8_BAR; PG8_SCHED;
            PG8_LDA(At, 0, 1); PG8_STAGE(PG8_SB(0, 0), b2, voffB); PG8_STAGE(PG8_SB(0, 1), b2 + hstep, voffB); PG8_STAGE(PG8_SA(0, 0), a2, voffA);
            PG8_WAIT_V(8); PG8_WAIT_L(0); PG8_BAR; PG8_MMA(1, 0, At, B0); PG8_MMA(1, 1, At, B1); PG8_BAR; PG8_SCHED;
            PG8_LDB(B0, 1, 0); PG8_LDB(B1, 1, 1); PG8_SCHED; PG8_LDA(At, 1, 0); PG8_STAGE(PG8_SA(0, 1), a2 + hstep, voffA);
            PG8_WAIT_V(8); PG8_WAIT_L(0); PG8_BAR; PG8_MMA(0, 0, At, B0); PG8_MMA(0, 1, At, B1); PG8_BAR; PG8_SCHED;
            PG8_LDA(At, 1, 1); PG8_STAGE(PG8_SB(1, 0), b3, voffB); PG8_STAGE(PG8_SB(1, 1), b3 + hstep, voffB); PG8_STAGE(PG8_SA(1, 0), a3, voffA);
            PG8_WAIT_V(8); PG8_WAIT_L(0); PG8_BAR; PG8_MMA(1, 0, At, B0); PG8_MMA(1, 1, At, B1); PG8_BAR; PG8_SCHED;
            } else {
            PG8_LDB(B0, 0, 0); PG8_SCHED; PG8_LDA(At, 0, 0); PG8_STAGE(PG8_SA(1, 1), a1 + hstep, voffA);
            PG8_WAIT_L(8); PG8_BAR; PG8_WAIT_L(0); PG8_MMA(0, 0, At, B0); PG8_BAR; PG8_SCHED;
            PG8_LDB(B1, 0, 1); PG8_STAGE(PG8_SB(0, 0), b2, voffB);
            PG8_BAR; PG8_WAIT_L(0); PG8_MMA(0, 1, At, B1); PG8_BAR;
            PG8_LDA(At, 0, 1); PG8_STAGE(PG8_SA(0, 0), a2, voffA);
            PG8_BAR; PG8_WAIT_L(0); PG8_MMA(1, 0, At, B0); PG8_BAR; PG8_SCHED;
            PG8_STAGE(PG8_SB(0, 1), b2 + hstep, voffB);
            PG8_WAIT_V(6); PG8_BAR; PG8_MMA(1, 1, At, B1); PG8_BAR;
            PG8_LDB(B0, 1, 0); PG8_SCHED; PG8_LDA(At, 1, 0); PG8_STAGE(PG8_SA(0, 1), a2 + hstep, voffA);
            PG8_WAIT_L(8); PG8_BAR; PG8_WAIT_L(0); PG8_MMA(0, 0, At, B0); PG8_BAR; PG8_SCHED;
            PG8_LDB(B1, 1, 1); PG8_STAGE(PG8_SB(1, 0), b3, voffB);
            PG8_BAR; PG8_WAIT_L(0); PG8_MMA(0, 1, At, B1); PG8_BAR;
            PG8_LDA(At, 1, 1); PG8_STAGE(PG8_SA(1, 0), a3, voffA);
            PG8_BAR; PG8_WAIT_L(0); PG8_MMA(1, 0, At, B0); PG8_BAR; PG8_SCHED;
            PG8_STAGE(PG8_SB(1, 1), b3 + hstep, voffB);
            PG8_WAIT_V(6); PG8_BAR; PG8_MMA(1, 1, At, B1); PG8_BAR;
            }
        }
        if constexpr (ALIGN_EPI) { if (wr == 0) PG8_BAR; }
        if constexpr (!Epi::AFTER_DRAIN) { E(acc, cur, wr, wc, fr, fq); S.done(cur); }
        if (!has_next) break;
#pragma unroll
        for (int a = 0; a < 2; ++a)
#pragma unroll
            for (int b = 0; b < 2; ++b)
#pragma unroll
                for (int m = 0; m < 4; ++m)
#pragma unroll
                    for (int n = 0; n < 2; ++n) acc[a][b][m][n] = (f32x4){0.f, 0.f, 0.f, 0.f};
        cur = nxt; cA = nA; cB = nB; ++ui;
        if constexpr (ALIGN_EPI) { if (wr == 1) PG8_BAR; }
    }
    PG8_WAIT_V(0);
    if constexpr (!ALIGN_EPI) { if (wr == 0) PG8_BAR; }
    PG8_BAR;
    if constexpr (Epi::AFTER_DRAIN) { E.fused(acc, cur, wr, wc, fr, fq, lds, wid, lane); S.done(cur); }
#undef PG8_SA
#undef PG8_SB
#undef PG8_STAGE
#undef PG8_LDA
#undef PG8_LDB
#undef PG8_MMA
#undef PG8_WAIT_V
#undef PG8_WAIT_L
#undef PG8_BAR
#undef PG8_SCHED
}
}

namespace pg8 {
template <int ACT> struct EpiBf16R {
    static constexpr bool PERM = true, AFTER_DRAIN = false;
    bf16_t* O; int ldc, pad;
    __device__ __forceinline__ void operator()(const f32x4 (&acc)[2][2][4][2], const Unit& u, int wr, int wc, int fr, int fq) const {
        const int row0 = u.pm * BM + wr * 64 + fr; const int col0 = u.pn * BM + wc * 32 + 8 * fq;
#pragma unroll
        for (int ai = 0; ai < 2; ++ai)
#pragma unroll
            for (int m = 0; m < 4; ++m) { bf16_t* rowp = O + (size_t)(row0 + ai * HALF + m * 16) * ldc + col0;
#pragma unroll
                for (int bj = 0; bj < 2; ++bj) { f32x4 v0 = acc[ai][bj][m][0], v1 = acc[ai][bj][m][1];
                    if (ACT == 2) {
#pragma unroll
                        for (int e = 0; e < 4; ++e) { float a = v0[e] > 0.f ? v0[e] : 0.f; v0[e] = a * a; float b = v1[e] > 0.f ? v1[e] : 0.f; v1[e] = b * b; } }
                    u32x4 w; w.x = cvt_pk_bf16(v0[0], v0[1]); w.y = cvt_pk_bf16(v0[2], v0[3]); w.z = cvt_pk_bf16(v1[0], v1[1]); w.w = cvt_pk_bf16(v1[2], v1[3]);
                    *(u32x4*)(rowp + bj * HALF) = w; } }
    }
};
struct EpiF32 {
    static constexpr bool PERM = false, AFTER_DRAIN = false;
    float* O; int ldc, pad;
    __device__ __forceinline__ void operator()(const f32x4 (&acc)[2][2][4][2], const Unit& u, int wr, int wc, int fr, int fq) const {
        const int col0 = u.pn * BM + wc * 32 + 4 * fq;
#pragma unroll
        for (int ai = 0; ai < 2; ++ai)
#pragma unroll
            for (int m = 0; m < 4; ++m) { const size_t off = (size_t)(u.pm * BM + ai * HALF + wr * 64 + m * 16 + fr) * ldc + col0;
#pragma unroll
                for (int bj = 0; bj < 2; ++bj)
#pragma unroll
                    for (int n = 0; n < 2; ++n) *(f32x4*)(O + off + bj * HALF + n * 16) = acc[ai][bj][m][n]; }
    }
};
}

namespace mk {
typedef unsigned short bf16;
typedef short bf16x8 __attribute__((ext_vector_type(8)));
typedef short s16x4 __attribute__((ext_vector_type(4)));
typedef float f32x4 __attribute__((ext_vector_type(4)));
typedef float f32x16 __attribute__((ext_vector_type(16)));
typedef unsigned u32x4 __attribute__((ext_vector_type(4)));
typedef unsigned u32x2 __attribute__((ext_vector_type(2)));
#define MK_LAS __attribute__((address_space(3)))

constexpr int BATCH = 4, SEQ = 8192, DM = 1024, DFF = 4096, MROWS = BATCH * SEQ, NPROJ = 3072, PIN = 3076, DEPTH = 2, NT = 512;
constexpr float EPS = 1e-6f, LOG2E = 1.4426950408889634f, NEGS = -30000.f, MINIT = -10000.f;
constexpr int PA_Q = 0, PA_K = 256, PA_V = 512, PB_G = 768, PB_X = 1024, PC_Z = 1280, PC_XBC = 1536, PD_Q = 2304, PD_K = 2560, PD_V = 2816;
constexpr int MX_A = 0, MX_B = 256, MX_C = 512, MX_D = 768;

constexpr size_t MiB = 1u << 20;
constexpr size_t WS_CTL = 0, WS_TBL = 1 * MiB, WS_W = 2 * MiB, W_LAYER = 24 * MiB, WS_DT = 52 * MiB, WS_LSUM = 53 * MiB, WS_CDEC = 54 * MiB,
                 WS_XN = 64 * MiB, WS_PROJ = 128 * MiB, WS_MIX = 320 * MiB, WS_HID = 128 * MiB, WS_Y1 = 128 * MiB, WS_Y2 = 384 * MiB, WS_ST = 384 * MiB, WS_CONV = 448 * MiB, WS_END = 512 * MiB;
constexpr size_t WO_IN = 0, WO_OUT = 6 * MiB, WO_UP = 8 * MiB, WO_DOWN = 16 * MiB;
constexpr size_t TB_D = 0  , TB_A = 32768  , TB_LAM = 40960  , TB_LRUW = 65536  ;
constexpr int LDS_BYTES = 147456;

enum { I_X = 0, I_RELB, I_NMPRE, I_NMPOST, I_NFPRE, I_NFPOST, I_WIN, I_WOUT, I_LCW, I_LCB, I_LWA, I_LBA, I_LWX, I_LBX, I_LLAM,
       I_SCW, I_SCB, I_SDTB, I_SALOG, I_SD, I_SNORM, I_LQ1, I_LK1, I_LQ2, I_LK2, I_DNORM, I_WUP, I_WDOWN, N_IN };
struct Params { const float* in[N_IN]; float* out; unsigned char* ws; };

__device__ __forceinline__ unsigned f2bf(float f) { unsigned u = __float_as_uint(f); return (u + 0x7fffu + ((u >> 16) & 1u)) >> 16; }
__device__ __forceinline__ float bf2f(unsigned short b) { return __uint_as_float(((unsigned)b) << 16); }
typedef float f32x2_t __attribute__((ext_vector_type(2))); typedef __bf16 bf16x2_t __attribute__((ext_vector_type(2)));
__device__ __forceinline__ unsigned pk2(float lo, float hi) { f32x2_t v = {lo, hi}; bf16x2_t b = __builtin_convertvector(v, bf16x2_t); return __builtin_bit_cast(unsigned, b); }
__device__ __forceinline__ int crow(int r, int hi) { return (r & 3) + 8 * (r >> 2) + 4 * hi; }
__device__ __forceinline__ float wave_sum(float v) {
#pragma unroll
    for (int o = 1; o < 64; o <<= 1) v += __shfl_xor(v, o);
    return v;
}
__device__ __forceinline__ int t5_bucket(int n) {
    if (n < 16) return n;
    return 16 + (n >= 22) + (n >= 30) + (n >= 40) + (n >= 54) + (n >= 73) + (n >= 99) + (n >= 134) + (n >= 182) + (n >= 246) + (n >= 332) + (n >= 450) + (n >= 609) + (n >= 825) + (n >= 1117) + (n >= 1513);
}
__device__ __forceinline__ f32x16 mfma32(bf16x8 a, bf16x8 b, f32x16 c) { return __builtin_amdgcn_mfma_f32_32x32x16_bf16(a, b, c, 0, 0, 0); }
__device__ __forceinline__ bf16x8 pack8(const f32x16& p, int base) {
    u32x4 w; w.x = pk2(p[base + 0], p[base + 1]); w.y = pk2(p[base + 2], p[base + 3]); w.z = pk2(p[base + 4], p[base + 5]); w.w = pk2(p[base + 6], p[base + 7]);
    return __builtin_bit_cast(bf16x8, w);
}
__device__ __forceinline__ bf16x8 pack8f(const float (&o)[8]) { u32x4 w; w.x = pk2(o[0], o[1]); w.y = pk2(o[2], o[3]); w.z = pk2(o[4], o[5]); w.w = pk2(o[6], o[7]); return __builtin_bit_cast(bf16x8, w); }
typedef short v4i16_t __attribute__((ext_vector_type(4)));
__device__ __forceinline__ s16x4 vtr(const unsigned char* p) {
    return __builtin_bit_cast(s16x4, __builtin_amdgcn_ds_read_tr16_b64_v4i16((MK_LAS v4i16_t*)(p)));
}
__device__ __forceinline__ bf16x8 vfrag(const unsigned char* p) {
    const s16x4 lo = vtr(p), hi = vtr(p + 512);
    return (bf16x8){lo[0], lo[1], lo[2], lo[3], hi[0], hi[1], hi[2], hi[3]};
}
#define MK_LDSFENCE() asm volatile("s_waitcnt lgkmcnt(0)" ::: "memory")
__device__ __forceinline__ float pl32max(float v) { const auto rr = __builtin_amdgcn_permlane32_swap(__float_as_uint(v), __float_as_uint(v), false, false); return fmaxf(__uint_as_float(rr[0]), __uint_as_float(rr[1])); }
__device__ __forceinline__ float pl32sum(float v) { const auto rr = __builtin_amdgcn_permlane32_swap(__float_as_uint(v), __float_as_uint(v), false, false); return __uint_as_float(rr[0]) + __uint_as_float(rr[1]); }

__device__ __forceinline__ void tr_item(const float* W, int K, int Nsrc, bf16* WT, int k0, int n0, bool remap, float* scr, int tid) {
    const int c = tid & 63, r0 = tid >> 6;
#pragma unroll
    for (int i = 0; i < 8; ++i) { const int k = r0 + 8 * i; const int n = n0 + c; const int sn = (remap && n >= 2304) ? n + 4 : n; scr[k * 65 + c] = W[(size_t)(k0 + k) * Nsrc + sn]; }
    __syncthreads();
#pragma unroll
    for (int i = 0; i < 8; ++i) { const int n = r0 + 8 * i; WT[(size_t)(n0 + n) * K + k0 + c] = (bf16)f2bf(scr[c * 65 + n]); }
    __syncthreads();
}
__device__ __forceinline__ void ph_prep(const Params& P, unsigned char* lds) {
    float* scr = (float*)lds; const int tid = mk_tid();
    constexpr int T_IN = 16 * 48, T_OUT = 16 * 16, T_UP = 16 * 64, T_DOWN = 64 * 16, T_L = T_IN + T_OUT + T_UP + T_DOWN;
    for (int it = blockIdx.x; it < DEPTH * T_L; it += gridDim.x) {
        const int layer = it / T_L; int r = it % T_L; bf16* wl = (bf16*)(P.ws + WS_W + (size_t)layer * W_LAYER);
        if (r < T_IN) { tr_item(P.in[I_WIN] + (size_t)layer * DM * PIN, DM, PIN, wl + WO_IN / 2, (r / 48) * 64, (r % 48) * 64, true, scr, tid); continue; } r -= T_IN;
        if (r < T_OUT) { tr_item(P.in[I_WOUT] + (size_t)layer * DM * DM, DM, DM, wl + WO_OUT / 2, (r / 16) * 64, (r % 16) * 64, false, scr, tid); continue; } r -= T_OUT;
        if (r < T_UP) { tr_item(P.in[I_WUP] + (size_t)layer * DM * DFF, DM, DFF, wl + WO_UP / 2, (r / 64) * 64, (r % 64) * 64, false, scr, tid); continue; } r -= T_UP;
        tr_item(P.in[I_WDOWN] + (size_t)layer * DFF * DM, DFF, DM, wl + WO_DOWN / 2, (r / 16) * 64, (r % 16) * 64, false, scr, tid);
    }
    const int gid = blockIdx.x * NT + tid, gn = gridDim.x * NT;
    const float* rb = P.in[I_RELB];
    float* tD = (float*)(P.ws + WS_TBL + TB_D); float* tA = (float*)(P.ws + WS_TBL + TB_A); float* tL = (float*)(P.ws + WS_TBL + TB_LAM);
    for (int i = gid; i < 4 * 2048; i += gn) { const int h = i >> 11, d = i & 2047; tD[i] = (rb[t5_bucket(d) * 8 + 4 + h] - rb[31 * 8 + 4 + h]) * LOG2E; }
    for (int i = gid; i < 3 * 4 * 132; i += gn) { const int p = i / (4 * 132), h = (i / 132) & 3, j = i % 132; const int dil = p == 0 ? 1 : (p == 1 ? 4 : 16);
        tA[i] = (j <= 128) ? rb[t5_bucket(j * dil) * 8 + h] * LOG2E : NEGS; }
    if (gid < DEPTH) { const int layer = gid; float s1 = 0.f, s2 = 0.f;
        for (int i = 0; i < 32; ++i) { s1 += P.in[I_LQ1][layer * 32 + i] * P.in[I_LK1][layer * 32 + i]; s2 += P.in[I_LQ2][layer * 32 + i] * P.in[I_LK2][layer * 32 + i]; }
        const float lam_init = 0.8f - 0.6f * expf(-0.3f * (float)layer); tL[layer] = expf(s1) - expf(s2) + lam_init; }
    bf16* lw = (bf16*)(P.ws + WS_TBL + TB_LRUW);
    for (int i = gid; i < DEPTH * 2 * 4 * 64 * 64; i += gn) { const int ii = i & 63, j = (i >> 6) & 63, hb = (i >> 12) & 3, g = (i >> 14) & 1, layer = i >> 15;
        const float* src = (g ? P.in[I_LWX] : P.in[I_LWA]) + (size_t)layer * 4 * 64 * 64; lw[i] = (bf16)f2bf(src[(hb * 64 + ii) * 64 + j]); }
}

__device__ __forceinline__ void ph_row(const float* Y, const float* gpost, const float* base, float* hout, const float* gnext, bf16* XN, const float* Wdt, float* DT) {
    const int tid_ = mk_tid(); const int lane = tid_ & 63, gw = blockIdx.x * (NT / 64) + (tid_ >> 6), ngw = gridDim.x * (NT / 64);
    for (int m = gw; m < MROWS; m += ngw) {
        f32x4 hv[4];
        const f32x4* bp = (const f32x4*)(base + (size_t)m * DM) + lane;
#pragma unroll
        for (int j = 0; j < 4; ++j) hv[j] = bp[64 * j];
        if (Y) {
            const f32x4* yp = (const f32x4*)(Y + (size_t)m * DM) + lane; f32x4 y[4]; float ss = 0.f;
#pragma unroll
            for (int j = 0; j < 4; ++j) { y[j] = yp[64 * j]; ss += (y[j].x * y[j].x + y[j].y * y[j].y) + (y[j].z * y[j].z + y[j].w * y[j].w); }
            ss = wave_sum(ss); const float r = 1.0f / sqrtf(ss * (1.0f / DM) + EPS);
            const f32x4* gp = (const f32x4*)gpost + lane; f32x4* hp = (f32x4*)(hout + (size_t)m * DM) + lane;
#pragma unroll
            for (int j = 0; j < 4; ++j) { hv[j] = hv[j] + y[j] * r * gp[64 * j]; hp[64 * j] = hv[j]; }
        }
        if (gnext) {
            float ss = 0.f;
#pragma unroll
            for (int j = 0; j < 4; ++j) ss += (hv[j].x * hv[j].x + hv[j].y * hv[j].y) + (hv[j].z * hv[j].z + hv[j].w * hv[j].w);
            ss = wave_sum(ss); const float r = 1.0f / sqrtf(ss * (1.0f / DM) + EPS);
            const f32x4* gp = (const f32x4*)gnext + lane; u32x2* xp = (u32x2*)(XN + (size_t)m * DM) + lane;
            f32x4 d = {0.f, 0.f, 0.f, 0.f};
#pragma unroll
            for (int j = 0; j < 4; ++j) { const f32x4 u = hv[j] * r * gp[64 * j]; u32x2 w; w.x = pk2(u.x, u.y); w.y = pk2(u.z, u.w); xp[64 * j] = w;
                if (Wdt) { const float* wp = Wdt + (size_t)(4 * (lane + 64 * j)) * PIN;
                    d = d + u.x * *(const f32x4*)(wp) + u.y * *(const f32x4*)(wp + PIN) + u.z * *(const f32x4*)(wp + 2 * PIN) + u.w * *(const f32x4*)(wp + 3 * PIN); } }
            if (Wdt) { d.x = wave_sum(d.x); d.y = wave_sum(d.y); d.z = wave_sum(d.z); d.w = wave_sum(d.w); if (lane == 0) *(f32x4*)(DT + (size_t)m * 4) = d; }
        }
    }
}

template <class Epi> __device__ __forceinline__ void ph_gemm(const pg8::Gemm g, const Epi e, unsigned char* lds) {
    pg8::StaticOrder S; S.init(g.M, g.N, (int)gridDim.x, (int)blockIdx.x);
    pg8::gemm_phase<Epi, pg8::StaticOrder, true, true>((PG8_LAS unsigned char*)lds, g, S, e);
}

__device__ __forceinline__ void ph_dilated(const Params& P, unsigned char* lds) {
    const int tid = mk_tid(), lane = tid & 63, wid = tid >> 6, r32 = lane & 31, hi = lane >> 5;
    float* tbl = (float*)lds;
    unsigned char* vst = lds + 13824 + wid * 4352;
    float* scr = (float*)(vst + 4096);
    const bf16* PROJ = (const bf16*)(P.ws + WS_PROJ); bf16* MIX = (bf16*)(P.ws + WS_MIX);
    const float* tA = (const float*)(P.ws + WS_TBL + TB_A);
    for (int item = blockIdx.x; item < 512; item += gridDim.x) {
        const int half = item & 1, chunk = (item >> 1) & 15, h = (item >> 5) & 3, b = item >> 7;
        __syncthreads();
        for (int i = tid; i < 3 * 1152; i += NT) { const int p = i / 1152, j = (i % 1152) - 496; tbl[i] = (j >= 0 && j <= 128) ? tA[(p * 4 + h) * 132 + j] : NEGS; }
        __syncthreads();
        const int rres = half * 8 + wid, T0 = chunk * 512, Tmax = T0 + rres + 496;
        const bf16* base = PROJ + (size_t)b * SEQ * NPROJ;
        bf16x8 qf[4];
        { const bf16* qp = base + (size_t)(T0 + rres + 16 * r32) * NPROJ + PA_Q + h * 64 + hi * 8; const float c2 = 0.125f * LOG2E;
#pragma unroll
          for (int s = 0; s < 4; ++s) { const bf16x8 q = *(const bf16x8*)(qp + 16 * s); u32x4 w;
              w.x = pk2(bf2f((bf16)q[0]) * c2, bf2f((bf16)q[1]) * c2); w.y = pk2(bf2f((bf16)q[2]) * c2, bf2f((bf16)q[3]) * c2);
              w.z = pk2(bf2f((bf16)q[4]) * c2, bf2f((bf16)q[5]) * c2); w.w = pk2(bf2f((bf16)q[6]) * c2, bf2f((bf16)q[7]) * c2); qf[s] = __builtin_bit_cast(bf16x8, w); } }
        float m = MINIT, l = 0.f; f32x16 o0 = {}, o1 = {};
        for (int p = 0; p < 3; ++p) {
            const int dl = p == 0 ? 1 : (p == 1 ? 4 : 16), rho = 16 / dl, ntile = (rho * 31 + 128) / 32 + 1, kmaxp = Tmax / dl, kq = rho * (31 - r32);
            for (int tau = 0; tau < ntile; ++tau) {
                const int k0 = 32 * tau;
                bf16x8 kf[4];
                { int pos = Tmax - dl * (k0 + r32); pos = pos < 0 ? 0 : pos; const bf16* kp = base + (size_t)pos * NPROJ + PA_K + h * 64 + hi * 8;
#pragma unroll
                  for (int s = 0; s < 4; ++s) kf[s] = *(const bf16x8*)(kp + 16 * s); }
#pragma unroll
                for (int i = 0; i < 4; ++i) { const int ci = lane + 64 * i, krow = ci >> 3, ch = ci & 7; int pos = Tmax - dl * (k0 + krow); pos = pos < 0 ? 0 : pos;
                    const bf16x8 v = *(const bf16x8*)(base + (size_t)pos * NPROJ + PA_V + h * 64 + ch * 8);
                    *(bf16x8*)(vst + ((ch >> 2) * 2 + (krow >> 4)) * 1024 + (krow & 15) * 64 + (ch & 3) * 16) = v; }
                f32x16 acc;
                { const float* tb = tbl + p * 1152 + (k0 + 4 * hi - kq + 496);
#pragma unroll
                  for (int r = 0; r < 16; ++r) acc[r] = tb[(r & 3) + 8 * (r >> 2)]; }
#pragma unroll
                for (int s = 0; s < 4; ++s) acc = mfma32(kf[s], qf[s], acc);
#pragma unroll
                for (int r = 0; r < 16; ++r) if (k0 + crow(r, hi) > kmaxp) acc[r] = NEGS;
                float mx = acc[0];
#pragma unroll
                for (int r = 1; r < 16; ++r) mx = fmaxf(mx, acc[r]);
                mx = pl32max(mx);
                const float mn = fmaxf(m, mx), f = __builtin_amdgcn_exp2f(m - mn); m = mn;
                float ps = 0.f;
#pragma unroll
                for (int r = 0; r < 16; ++r) { acc[r] = __builtin_amdgcn_exp2f(acc[r] - mn); ps += acc[r]; }
                l = l * f + ps;
                if (__any(f != 1.0f)) {
                    if (hi == 0) scr[r32] = f;
                    MK_LDSFENCE();
#pragma unroll
                    for (int r = 0; r < 16; ++r) { const float fr = scr[crow(r, hi)]; o0[r] *= fr; o1[r] *= fr; }
                }
                MK_LDSFENCE();
                const unsigned char* vb = vst + ((lane >> 4) & 1) * 32 + (lane & 3) * 8 + (4 * hi + ((lane & 15) >> 2)) * 64;
#pragma unroll
                for (int ks = 0; ks < 2; ++ks) { const bf16x8 pa = pack8(acc, 8 * ks);
                    o0 = mfma32(pa, vfrag(vb + ks * 1024), o0); o1 = mfma32(pa, vfrag(vb + 2048 + ks * 1024), o1); }
                MK_LDSFENCE();
            }
        }
        l = pl32sum(l);
        if (hi == 0) scr[r32] = 1.0f / l;
        MK_LDSFENCE();
#pragma unroll
        for (int r = 0; r < 16; ++r) { const int q = crow(r, hi); const float inv = scr[q];
            bf16* op = MIX + ((size_t)b * SEQ + T0 + rres + 16 * q) * DM + MX_A + h * 64 + r32;
            op[0] = (bf16)f2bf(o0[r] * inv); op[32] = (bf16)f2bf(o1[r] * inv); }
        MK_LDSFENCE();
    }
}

constexpr float DTHR = 6.0f;
__device__ __forceinline__ float max16(const f32x16& a, const f32x16& b) {
    float x = fmaxf(fmaxf(a[0], a[1]), b[0]), y = fmaxf(fmaxf(a[2], a[3]), b[1]); x = fmaxf(fmaxf(x, b[2]), b[3]);
#pragma unroll
    for (int r = 4; r < 16; r += 4) { x = fmaxf(fmaxf(x, a[r]), a[r + 1]); y = fmaxf(fmaxf(y, a[r + 2]), a[r + 3]); x = fmaxf(fmaxf(x, b[r]), b[r + 1]); y = fmaxf(fmaxf(y, b[r + 2]), b[r + 3]); }
    return fmaxf(x, y);
}
__device__ __forceinline__ void diff_softmax(f32x16& s0, f32x16& s1, float& m, float& l, f32x16& oa, f32x16& ob, float* scr, bool first, int r32, int hi) {
    const float mx = pl32max(max16(s0, s1));
    if (first || __any(mx > DTHR)) {
        const float dl = first ? mx : fmaxf(mx, 0.f); m += dl;
#pragma unroll
        for (int r = 0; r < 16; ++r) { s0[r] -= dl; s1[r] -= dl; }
        const float f = first ? 0.f : __builtin_amdgcn_exp2f(-dl); l *= f;
        if (hi == 0) scr[r32] = f;
        MK_LDSFENCE();
#pragma unroll
        for (int r = 0; r < 16; ++r) { const float fr = scr[crow(r, hi)]; oa[r] *= fr; ob[r] *= fr; }
        MK_LDSFENCE();
    }
    float ps = 0.f;
#pragma unroll
    for (int r = 0; r < 16; ++r) { s0[r] = __builtin_amdgcn_exp2f(s0[r]); ps += s0[r]; }
#pragma unroll
    for (int r = 0; r < 16; ++r) { s1[r] = __builtin_amdgcn_exp2f(s1[r]); ps += s1[r]; }
    l += ps;
}
__device__ __forceinline__ void diff_unit(const Params& P, int layer, int b, int h, int qb, unsigned char* lds) {
    const int tid = mk_tid(), lane = tid & 63, wid = tid >> 6, r32 = lane & 31, hi = lane >> 5;
    unsigned char* Kb = lds;
    unsigned char* Vb = lds + 16384;
    const float* tbl = (const float*)(lds + 32768);
    float* scr = (float*)(lds + 40960) + wid * 64;
    const bf16* PROJ = (const bf16*)(P.ws + WS_PROJ); bf16* MIX = (bf16*)(P.ws + WS_MIX);
    const unsigned rowb = (unsigned)b * SEQ;
    const int q0 = qb * 256, qw0 = q0 + 32 * wid, qabs = qw0 + r32, NTL = 4 * qb + 4;
    bf16x8 qf[2][2];
    { const unsigned qo = (rowb + qabs) * NPROJ + PD_Q + h * 64 + hi * 8; const float c2 = 0.17677669529663687f * LOG2E;
#pragma unroll
      for (int c = 0; c < 2; ++c)
#pragma unroll
          for (int s = 0; s < 2; ++s) { const bf16x8 q = *(const bf16x8*)(PROJ + (qo + c * 32 + 16 * s)); float o[8];
#pragma unroll
              for (int e = 0; e < 8; ++e) o[e] = bf2f((bf16)q[e]) * c2;
              qf[c][s] = pack8f(o); } }
    const int lrow = tid >> 3, lch = tid & 7;
    const unsigned kgo = (rowb + lrow) * NPROJ + PD_K + h * 64 + lch * 8, vgo = (rowb + lrow) * NPROJ + PD_V + h * 64 + lch * 8;
    const int kdst = lrow * 128 + ((lch ^ (lrow & 7)) * 16), vdst = ((lch >> 2) * 4 + (lrow >> 4)) * 1024 + (lrow & 15) * 64 + (lch & 3) * 16;
    { const bf16x8 k = *(const bf16x8*)(PROJ + kgo), v = *(const bf16x8*)(PROJ + vgo); *(bf16x8*)(Kb + kdst) = k; *(bf16x8*)(Vb + vdst) = v; }
    float m0 = 0.f, m1 = 0.f, l0 = 0.f, l1 = 0.f; f32x16 o00 = {}, o01 = {}, o10 = {}, o11 = {};
    __syncthreads();
#pragma unroll 1
    for (int j = 0; j < NTL; ++j) {
        bf16x8 kn = {}, vn = {};
        if (j + 1 < NTL) { kn = *(const bf16x8*)(PROJ + (kgo + (unsigned)(j + 1) * 64 * NPROJ)); vn = *(const bf16x8*)(PROJ + (vgo + (unsigned)(j + 1) * 64 * NPROJ)); }
        const int k0 = 64 * j;
        if (k0 <= qw0 + 31) {
            const unsigned char* Kt = Kb + (j & 1) * 8192; const unsigned char* Vt = Vb + (j & 1) * 8192;
            f32x16 s00, s01, s10, s11;
            const bool near = (qw0 - k0 - 63) < 1513;
            { f32x16 i0, i1;
              if (near) { const int dq = qabs - k0 - 4 * hi;
#pragma unroll
                  for (int r = 0; r < 16; ++r) { int d = dq - ((r & 3) + 8 * (r >> 2)); int d1 = d - 32; d = d < 0 ? 0 : d; d1 = d1 < 0 ? 0 : d1; i0[r] = tbl[d]; i1[r] = tbl[d1]; } }
              else {
#pragma unroll
                  for (int r = 0; r < 16; ++r) { i0[r] = 0.f; i1[r] = 0.f; } }
#pragma unroll
              for (int r = 0; r < 16; ++r) { s00[r] = i0[r] - m0; s01[r] = i1[r] - m0; s10[r] = i0[r] - m1; s11[r] = i1[r] - m1; } }
            { const unsigned char* kr0 = Kt + r32 * 128; const unsigned char* kr1 = Kt + (32 + r32) * 128; const int sw = r32 & 7;
#pragma unroll
              for (int s = 0; s < 2; ++s) {
                  s00 = mfma32(*(const bf16x8*)(kr0 + (((2 * s + hi) ^ sw) * 16)), qf[0][s], s00);
                  s01 = mfma32(*(const bf16x8*)(kr1 + (((2 * s + hi) ^ sw) * 16)), qf[0][s], s01);
                  s10 = mfma32(*(const bf16x8*)(kr0 + (((4 + 2 * s + hi) ^ sw) * 16)), qf[1][s], s10);
                  s11 = mfma32(*(const bf16x8*)(kr1 + (((4 + 2 * s + hi) ^ sw) * 16)), qf[1][s], s11); } }
            if (k0 + 63 > qw0) {
#pragma unroll
                for (int r = 0; r < 16; ++r) { const int kk = k0 + crow(r, hi);
                    if (kk > qabs) { s00[r] = NEGS; s10[r] = NEGS; } if (kk + 32 > qabs) { s01[r] = NEGS; s11[r] = NEGS; } }
            }
            const unsigned char* vb = Vt + ((lane >> 4) & 1) * 32 + (lane & 3) * 8 + (4 * hi + ((lane & 15) >> 2)) * 64;
            bf16x8 vf[4][2];
#pragma unroll
            for (int ks = 0; ks < 4; ++ks) { vf[ks][0] = vfrag(vb + ks * 1024); vf[ks][1] = vfrag(vb + 4096 + ks * 1024); }
            diff_softmax(s00, s01, m0, l0, o00, o01, scr, j == 0, r32, hi);
#pragma unroll
            for (int ks = 0; ks < 4; ++ks) { const bf16x8 p = (ks < 2) ? pack8(s00, 8 * (ks & 1)) : pack8(s01, 8 * (ks & 1)); o00 = mfma32(p, vf[ks][0], o00); o01 = mfma32(p, vf[ks][1], o01); }
            diff_softmax(s10, s11, m1, l1, o10, o11, scr, j == 0, r32, hi);
#pragma unroll
            for (int ks = 0; ks < 4; ++ks) { const bf16x8 p = (ks < 2) ? pack8(s10, 8 * (ks & 1)) : pack8(s11, 8 * (ks & 1)); o10 = mfma32(p, vf[ks][0], o10); o11 = mfma32(p, vf[ks][1], o11); }
        }
        if (j + 1 < NTL) { *(bf16x8*)(Kb + ((j + 1) & 1) * 8192 + kdst) = kn; *(bf16x8*)(Vb + ((j + 1) & 1) * 8192 + vdst) = vn; }
        __syncthreads();
    }
    const float lam = ((const float*)(P.ws + WS_TBL + TB_LAM))[layer];
    const float lam_init = 0.8f - 0.6f * expf(-0.3f * (float)layer);
    l0 = pl32sum(l0); l1 = pl32sum(l1);
    if (hi == 0) { scr[r32] = 1.0f / l0; scr[32 + r32] = lam / l1; }
    MK_LDSFENCE();
    const float* gn = P.in[I_DNORM] + layer * 64;
    const float g0 = gn[r32] * (1.0f - lam_init), g1 = gn[32 + r32] * (1.0f - lam_init);
#pragma unroll
    for (int r = 0; r < 16; ++r) { const int q = crow(r, hi); const float i0 = scr[q], i1 = scr[32 + q];
        const float a = o00[r] * i0 - o10[r] * i1, c = o01[r] * i0 - o11[r] * i1;
        float ss = a * a + c * c;
#pragma unroll
        for (int x = 1; x < 32; x <<= 1) ss += __shfl_xor(ss, x);
        const float rs = 1.0f / sqrtf(ss * (1.0f / 64.0f) + EPS);
        bf16* op = MIX + ((rowb + qw0 + q) * DM + MX_D + h * 64 + r32);
        op[0] = (bf16)f2bf(a * rs * g0); op[32] = (bf16)f2bf(c * rs * g1); }
    MK_LDSFENCE();
}
__device__ __forceinline__ void ph_diff(const Params& P, int layer, unsigned char* lds) {
    const float* tD = (const float*)(P.ws + WS_TBL + TB_D);
    for (int item = blockIdx.x; item < 256; item += gridDim.x) {
        const int bh = item >> 4, s = item & 15, b = bh >> 2, h = bh & 3;
        __syncthreads();
        for (int i = mk_tid(); i < 2048; i += NT) ((float*)(lds + 32768))[i] = tD[h * 2048 + i];
        __syncthreads();
        diff_unit(P, layer, b, h, 31 - s, lds);
        __syncthreads();
        diff_unit(P, layer, b, h, s, lds);
    }
}

__device__ __forceinline__ float sigm(float v) { return 1.0f / (1.0f + __expf(-v)); }
__device__ __forceinline__ float gelu_tanh(float x) { const float u = 0.7978845608028654f * (x + 0.044715f * x * x * x); return x * sigm(2.0f * u); }
__device__ __forceinline__ void ph_conv(const Params& P, int layer) {
    const bf16* PROJ = (const bf16*)(P.ws + WS_PROJ); bf16* CONVB = (bf16*)(P.ws + WS_CONV);
    const int gid = blockIdx.x * NT + mk_tid();
    for (int it = gid; it < 128 * (MROWS / 16); it += gridDim.x * NT) {
        const int cg = it & 127, seg = it >> 7, m0 = seg * 16, t = m0 & (SEQ - 1);
        const bool lru = cg < 32;
        const int pcol = lru ? PB_X + 8 * cg : PC_XBC + 8 * (cg - 32);
        const float* cw = lru ? P.in[I_LCW] + layer * 4 * 256 + 8 * cg : P.in[I_SCW] + layer * 4 * 768 + 8 * (cg - 32);
        const float* cb = lru ? P.in[I_LCB] + layer * 256 + 8 * cg : P.in[I_SCB] + layer * 768 + 8 * (cg - 32);
        const int wst = lru ? 256 : 768;
        const f32x4 b0 = *(const f32x4*)cb, b1 = *(const f32x4*)(cb + 4);
        const f32x4 w00 = *(const f32x4*)cw, w01 = *(const f32x4*)(cw + 4), w10 = *(const f32x4*)(cw + wst), w11 = *(const f32x4*)(cw + wst + 4);
        const f32x4 w20 = *(const f32x4*)(cw + 2 * wst), w21 = *(const f32x4*)(cw + 2 * wst + 4), w30 = *(const f32x4*)(cw + 3 * wst), w31 = *(const f32x4*)(cw + 3 * wst + 4);
        const unsigned xo = (unsigned)m0 * NPROJ + pcol;
        const bf16x8 z8 = {0, 0, 0, 0, 0, 0, 0, 0};
        bf16x8 x1 = t >= 1 ? *(const bf16x8*)(PROJ + (xo - NPROJ)) : z8, x2 = t >= 2 ? *(const bf16x8*)(PROJ + (xo - 2 * NPROJ)) : z8, x3 = t >= 3 ? *(const bf16x8*)(PROJ + (xo - 3 * NPROJ)) : z8;
#pragma unroll 4
        for (int i = 0; i < 16; ++i) { const bf16x8 x0 = *(const bf16x8*)(PROJ + (xo + (unsigned)i * NPROJ)); float o[8];
#pragma unroll
            for (int e = 0; e < 4; ++e) {
                o[e] = b0[e] + w00[e] * bf2f((bf16)x3[e]) + w10[e] * bf2f((bf16)x2[e]) + w20[e] * bf2f((bf16)x1[e]) + w30[e] * bf2f((bf16)x0[e]);
                o[4 + e] = b1[e] + w01[e] * bf2f((bf16)x3[4 + e]) + w11[e] * bf2f((bf16)x2[4 + e]) + w21[e] * bf2f((bf16)x1[4 + e]) + w31[e] * bf2f((bf16)x0[4 + e]); }
            if (!lru) {
#pragma unroll
                for (int e = 0; e < 8; ++e) o[e] = o[e] * sigm(o[e]); }
            *(bf16x8*)(CONVB + ((unsigned)(m0 + i) * DM + 8 * cg)) = pack8f(o);
            x3 = x2; x2 = x1; x1 = x0; }
    }
}
template <int pass> __device__ __forceinline__ void ph_lru(const Params& P, int layer) {
    const int tid = mk_tid(), lane = tid & 63, wid = tid >> 6, r32 = lane & 31, hi = lane >> 5;
    const bf16* PROJ = (const bf16*)(P.ws + WS_PROJ); bf16* MIX = (bf16*)(P.ws + WS_MIX);
    float* LSUM = (float*)(P.ws + WS_LSUM); const float* LCAR = (const float*)(P.ws + WS_LSUM + 524288);
    const bf16* CONVB = (const bf16*)(P.ws + WS_CONV);
    const bf16* WT = (const bf16*)(P.ws + WS_TBL + TB_LRUW) + (size_t)layer * 2 * 4 * 64 * 64;
    const int hb = wid >> 1, nt = wid & 1, ch = hb * 64 + 32 * nt + r32;
    bf16x8 wa[4], wx[4];
#pragma unroll
    for (int ks = 0; ks < 4; ++ks) { wa[ks] = *(const bf16x8*)(WT + ((size_t)(hb * 64 + 32 * nt + r32)) * 64 + 16 * ks + 8 * hi);
        wx[ks] = *(const bf16x8*)(WT + ((size_t)((4 + hb) * 64 + 32 * nt + r32)) * 64 + 16 * ks + 8 * hi); }
    bf16x8 idf[2];
#pragma unroll
    for (int kk = 0; kk < 2; ++kk)
#pragma unroll
        for (int e = 0; e < 8; ++e) idf[kk][e] = (r32 == 16 * kk + 8 * hi + e) ? (short)0x3F80 : (short)0;
    const float sp = log1pf(expf(-P.in[I_LLAM][layer * 256 + ch])), bav = P.in[I_LBA][layer * 256 + ch], bxv = P.in[I_LBX][layer * 256 + ch];
    for (int item = blockIdx.x; item < 256; item += gridDim.x) {
        const int b = item >> 6, c = item & 63;
        float hst = 0.f, aprod = 1.f;
        if (pass == 1) hst = LCAR[(unsigned)((b * 64 + c) * 256 + ch)];
#pragma unroll 1
        for (int sc = 0; sc < 4; ++sc) {
            const int tl0 = c * 128 + sc * 32, t = tl0 + r32;
            bf16x8 af[4];
            const unsigned xo = (unsigned)(b * SEQ + t) * DM + hb * 64 + 8 * hi;
#pragma unroll
            for (int ks = 0; ks < 4; ++ks) af[ks] = *(const bf16x8*)(CONVB + (xo + 16 * ks));
            f32x16 accr = {}, acci = {}, accx = {};
#pragma unroll
            for (int ks = 0; ks < 4; ++ks) { accr = mfma32(af[ks], wa[ks], accr); acci = mfma32(af[ks], wx[ks], acci); }
            { const bf16x8 a0 = nt ? af[2] : af[0], a1 = nt ? af[3] : af[1]; accx = mfma32(a0, idf[0], accx); accx = mfma32(a1, idf[1], accx); }
            float av[16], bv[16];
#pragma unroll
            for (int r = 0; r < 16; ++r) { const float rg = sigm(accr[r] + bav), ig = sigm(acci[r] + bxv); const float la = -8.0f * rg * sp; const float a = __expf(la);
                av[r] = a; bv[r] = sqrtf(fmaxf(1.0f - a * a, 0.f)) * (ig * accx[r]); }
            float Ag[4], Hg[4], Ao[4], Ho[4], cin[4];
#pragma unroll
            for (int gi = 0; gi < 4; ++gi) { float A = 1.f, H = 0.f;
#pragma unroll
                for (int e = 0; e < 4; ++e) { H = av[4 * gi + e] * H + bv[4 * gi + e]; A *= av[4 * gi + e]; }
                Ag[gi] = A; Hg[gi] = H; Ao[gi] = __shfl_xor(A, 32); Ho[gi] = __shfl_xor(H, 32); }
            float carry = hst;
#pragma unroll
            for (int gi = 0; gi < 4; ++gi) { const float A0 = hi ? Ao[gi] : Ag[gi], H0 = hi ? Ho[gi] : Hg[gi], A1 = hi ? Ag[gi] : Ao[gi], H1 = hi ? Hg[gi] : Ho[gi];
                const float c0 = carry; carry = A0 * carry + H0; const float c1 = carry; carry = A1 * carry + H1; cin[gi] = hi ? c1 : c0; aprod *= A0 * A1; }
            hst = carry;
            if (pass == 1) {
                const unsigned rowq = (unsigned)(b * SEQ + tl0 + 4 * hi);
#pragma unroll
                for (int gi = 0; gi < 4; ++gi) { float h = cin[gi];
                    asm volatile("" ::: "memory");
#pragma unroll
                    for (int e = 0; e < 4; ++e) { const int r = 4 * gi + e; h = av[r] * h + bv[r]; const unsigned row = rowq + 8 * gi + e;
                        const float g = bf2f(PROJ[row * NPROJ + PB_G + ch]); MIX[row * DM + MX_B + ch] = (bf16)f2bf(gelu_tanh(g) * h); } }
            }
        }
        if (pass == 0 && hi == 0) { LSUM[(unsigned)((b * 64 + c) * 512 + ch)] = aprod; LSUM[(unsigned)((b * 64 + c) * 512 + 256 + ch)] = hst; }
    }
}

__device__ __forceinline__ float softplusf(float v) { return v > 20.f ? v : log1pf(expf(v)); }
__device__ __forceinline__ bf16x8 trfrag(const unsigned char* tile, int ks, int ct, int lane) {
    const unsigned char* p = tile + (16 * ks + 4 * (lane >> 5) + ((lane & 15) >> 2)) * 272 + (32 * ct + 16 * ((lane >> 4) & 1) + 4 * (lane & 3)) * 2;
    const s16x4 lo = vtr(p), hi = vtr(p + 8 * 272);
    return (bf16x8){lo[0], lo[1], lo[2], lo[3], hi[0], hi[1], hi[2], hi[3]};
}
template <int pass> __device__ __forceinline__ void ph_ssd(const Params& P, int layer, unsigned char* lds) {
    const int tid = mk_tid(), lane = tid & 63, wid = tid >> 6, r32 = lane & 31, hi = lane >> 5;
    unsigned char* R0 = lds; unsigned char* R1 = lds + 34816; unsigned char* R2 = lds + 2 * 34816; unsigned char* R3 = lds + 3 * 34816;
    float* dtv = (float*)(lds + 4 * 34816); float* acum = dtv + 256; float* wsc = acum + 256; float* tot = wsc + 256; float* rstd = tot + 8;
    float* YB = (float*)lds;
    const bf16* PROJ = (const bf16*)(P.ws + WS_PROJ); bf16* MIX = (bf16*)(P.ws + WS_MIX);
    const float* DT = (const float*)(P.ws + WS_DT); float* ST = (float*)(P.ws + WS_ST); float* CD = (float*)(P.ws + WS_CDEC);
    const bf16* CONVB = (const bf16*)(P.ws + WS_CONV);
    for (int item = blockIdx.x; item < 512; item += gridDim.x) {
        const int g = item & 1, c = (item >> 1) & 63, b = item >> 7, t0 = c * 128; const unsigned rowb = (unsigned)b * SEQ;
        int tv = tid; asm volatile("" : "+v"(tv));
        __syncthreads();
        if (tid < 256) { const int s = tid & 127, hl = tid >> 7, hh = 2 * g + hl;
            const float dt = softplusf(DT[(rowb + t0 + s) * 4 + hh] + P.in[I_SDTB][layer * 4 + hh]); float v = dt * -expf(P.in[I_SALOG][layer * 4 + hh]);
#pragma unroll
            for (int o = 1; o < 64; o <<= 1) { const float u = __shfl_up(v, o); if (lane >= o) v += u; }
            dtv[tid] = dt; acum[tid] = v; if (lane == 63) tot[wid] = v; }
        __syncthreads();
        if (tid < 256 && (tid & 64)) acum[tid] += tot[wid - 1];
        __syncthreads();
        if (pass == 0) { if (tid < 256) wsc[tid] = dtv[tid] * __expf(acum[(tid & 128) + 127] - acum[tid]); __syncthreads(); }
        { constexpr int NCH = pass == 0 ? 8 : 12;
#pragma unroll
          for (int i = 0; i < NCH; ++i) { const int idx = tv + NT * i, tile = idx >> 11, row = (idx >> 4) & 127, c16 = idx & 15;
              bf16x8 v = *(const bf16x8*)(CONVB + ((rowb + t0 + row) * DM + 256 + 256 * tile + g * 128 + 8 * c16));
              if (pass == 0 && tile == 0) { const float sc = wsc[(c16 >> 3) * 128 + row]; float o[8];
#pragma unroll
                  for (int e = 0; e < 8; ++e) o[e] = bf2f((bf16)v[e]) * sc;
                  v = pack8f(o); }
              unsigned char* dst = (tile == 0 ? (pass == 0 ? R0 : R2) : (tile == 1 ? R1 : R0));
              *(bf16x8*)(dst + row * 272 + c16 * 16) = v; } }
        const int mt = wid >> 1, nt0 = 2 * (wid & 1);
        if (pass == 0) {
            __syncthreads();
            f32x16 acc[2]; acc[0] = f32x16{}; acc[1] = f32x16{};
#pragma unroll
            for (int ks = 0; ks < 8; ++ks) { const bf16x8 a = trfrag(R0, ks, mt, lane); acc[0] = mfma32(a, trfrag(R1, ks, nt0, lane), acc[0]); acc[1] = mfma32(a, trfrag(R1, ks, nt0 + 1, lane), acc[1]); }
#pragma unroll
            for (int j = 0; j < 2; ++j)
#pragma unroll
                for (int r = 0; r < 16; ++r) { const int pl = 32 * mt + crow(r, hi), hh = 2 * g + (pl >> 6); ST[(unsigned)(((b * 64 + c) * 4 + hh) * 8192 + (pl & 63) * 128 + 32 * (nt0 + j) + r32)] = acc[j][r]; }
            if (tid < 2) CD[(b * 64 + c) * 4 + 2 * g + tid] = __expf(acum[tid * 128 + 127]);
        } else {
#pragma unroll
            for (int i = 0; i < 8; ++i) { const int idx = tv + NT * i, pl = idx >> 5, n4 = (idx & 31) * 4;
                const f32x4 v = *(const f32x4*)(ST + (unsigned)(((b * 64 + c) * 4 + 2 * g + (pl >> 6)) * 8192 + (pl & 63) * 128 + n4));
                u32x2 w; w.x = pk2(v.x, v.y); w.y = pk2(v.z, v.w); *(u32x2*)(R3 + pl * 272 + n4 * 2) = w; }
            __syncthreads();
            f32x16 cbt[2], ya[2]; cbt[0] = f32x16{}; cbt[1] = f32x16{}; ya[0] = f32x16{}; ya[1] = f32x16{};
#pragma unroll 2
            for (int ks = 0; ks < 8; ++ks) { const int ko = (16 * ks + 8 * hi) * 2; const bf16x8 a = *(const bf16x8*)(R0 + (32 * mt + r32) * 272 + ko);
                cbt[0] = mfma32(a, *(const bf16x8*)(R1 + (32 * nt0 + r32) * 272 + ko), cbt[0]);
                cbt[1] = mfma32(a, *(const bf16x8*)(R1 + (32 * (nt0 + 1) + r32) * 272 + ko), cbt[1]);
                ya[0] = mfma32(a, *(const bf16x8*)(R3 + (32 * (wid & 1) + r32) * 272 + ko), ya[0]);
                ya[1] = mfma32(a, *(const bf16x8*)(R3 + (64 + 32 * (wid & 1) + r32) * 272 + ko), ya[1]); }
#pragma unroll
            for (int hl = 0; hl < 2; ++hl)
#pragma unroll
                for (int r = 0; r < 16; ++r) ya[hl][r] *= __expf(acum[hl * 128 + 32 * mt + crow(r, hi)]);
            __syncthreads();
#pragma unroll
            for (int hl = 0; hl < 2; ++hl) { unsigned char* dstm = hl ? R0 : R1;
#pragma unroll
                for (int j = 0; j < 2; ++j) { const int s = 32 * (nt0 + j) + r32; const float as = acum[hl * 128 + s], ds = dtv[hl * 128 + s];
#pragma unroll
                    for (int r = 0; r < 16; ++r) { const int lrow = 32 * mt + crow(r, hi);
                        const float v = (s <= lrow) ? cbt[j][r] * __expf(fminf(acum[hl * 128 + lrow] - as, 0.f)) * ds : 0.f; *(bf16*)(dstm + lrow * 272 + s * 2) = (bf16)f2bf(v); } } }
            __syncthreads();
#pragma unroll
            for (int hl = 0; hl < 2; ++hl) { const unsigned char* Mh = (hl ? R0 : R1) + (32 * mt + r32) * 272 + 8 * hi; const int pt = 2 * hl + (wid & 1);
#pragma unroll 2
                for (int ks = 0; ks < 8; ++ks) { const s16x4 lo = *(const s16x4*)(Mh + 32 * ks), h4 = *(const s16x4*)(Mh + 32 * ks + 16);
                    ya[hl] = mfma32((bf16x8){lo[0], lo[1], lo[2], lo[3], h4[0], h4[1], h4[2], h4[3]}, trfrag(R2, ks, pt, lane), ya[hl]); } }
#pragma unroll
            for (int hl = 0; hl < 2; ++hl) { const int hh = 2 * g + hl, pl = 64 * hl + 32 * (wid & 1) + r32; const float dsk = P.in[I_SD][layer * 4 + hh];
#pragma unroll
                for (int r = 0; r < 16; ++r) { const int lrow = 32 * mt + crow(r, hi); const float xv = bf2f(*(const bf16*)(R2 + lrow * 272 + pl * 2));
                    const float z = bf2f(PROJ[(rowb + t0 + lrow) * NPROJ + PC_Z + hh * 64 + (pl & 63)]); ya[hl][r] = (ya[hl][r] + dsk * xv) * (z * sigm(z)); } }
            __syncthreads();
#pragma unroll
            for (int hl = 0; hl < 2; ++hl) { const int pl = 64 * hl + 32 * (wid & 1) + r32;
#pragma unroll
                for (int r = 0; r < 16; ++r) YB[(32 * mt + crow(r, hi)) * 132 + pl] = ya[hl][r]; }
            __syncthreads();
            { const int lrow = tv >> 2, q = tv & 3; const float* yr = YB + lrow * 132 + q; float ss = 0.f;
#pragma unroll
              for (int e = 0; e < 32; ++e) ss += yr[4 * e] * yr[4 * e];
              ss += __shfl_xor(ss, 1); ss += __shfl_xor(ss, 2);
              if (q == 0) rstd[lrow] = 1.0f / sqrtf(ss * (1.0f / 128.0f) + EPS); }
            __syncthreads();
#pragma unroll
            for (int i = 0; i < 4; ++i) { const int idx = tv + NT * i, lrow = idx >> 4, cn = idx & 15; const float rs = rstd[lrow];
                const f32x4 y0 = *(const f32x4*)(YB + lrow * 132 + 8 * cn), y1 = *(const f32x4*)(YB + lrow * 132 + 8 * cn + 4);
                const float* gn = P.in[I_SNORM] + layer * 256 + g * 128 + 8 * cn; const f32x4 g0 = *(const f32x4*)gn, g1 = *(const f32x4*)(gn + 4);
                u32x4 w; w.x = pk2(y0.x * rs * g0.x, y0.y * rs * g0.y); w.y = pk2(y0.z * rs * g0.z, y0.w * rs * g0.w); w.z = pk2(y1.x * rs * g1.x, y1.y * rs * g1.y); w.w = pk2(y1.z * rs * g1.z, y1.w * rs * g1.w);
                *(u32x4*)(MIX + (rowb + t0 + lrow) * DM + MX_C + g * 128 + 8 * cn) = w; }
        }
    }
}
__device__ __forceinline__ void ph_scan(const Params& P) {
    float* ST = (float*)(P.ws + WS_ST); const float* CD = (const float*)(P.ws + WS_CDEC);
    const int gid = blockIdx.x * NT + mk_tid();
    for (int e = gid; e < BATCH * 4 * 8192; e += gridDim.x * NT) {
        const int b = e >> 15, hh = (e >> 13) & 3, pn = e & 8191; float carry = 0.f;
#pragma unroll 1
        for (int c0 = 0; c0 < 64; c0 += 8) { float st[8], cd[8];
#pragma unroll
            for (int i = 0; i < 8; ++i) { st[i] = ST[((size_t)((b * 64 + c0 + i) * 4 + hh)) * 8192 + pn]; cd[i] = CD[(b * 64 + c0 + i) * 4 + hh]; }
#pragma unroll
            for (int i = 0; i < 8; ++i) { ST[((size_t)((b * 64 + c0 + i) * 4 + hh)) * 8192 + pn] = carry; carry = carry * cd[i] + st[i]; } }
    }
    const float* LSUM = (const float*)(P.ws + WS_LSUM); float* LCAR = (float*)(P.ws + WS_LSUM + 524288);
    if (gid < BATCH * 256) { const int b = gid >> 8, ch = gid & 255; float carry = 0.f;
#pragma unroll 1
        for (int c0 = 0; c0 < 64; c0 += 8) { float a[8], h[8];
#pragma unroll
            for (int i = 0; i < 8; ++i) { a[i] = LSUM[(size_t)(b * 64 + c0 + i) * 512 + ch]; h[i] = LSUM[(size_t)(b * 64 + c0 + i) * 512 + 256 + ch]; }
#pragma unroll
            for (int i = 0; i < 8; ++i) { LCAR[(size_t)(b * 64 + c0 + i) * 256 + ch] = carry; carry = a[i] * carry + h[i]; } }
    }
}

#define LAS __attribute__((address_space(3)))
#define XB_TMO      128
#define XB_XCNT(j)  (256  + 64 * (j))
#define XB_XSUB(j)  (1280 + 64 * (j))
#define XB_XGEN(j)  (2304 + 64 * (j))
#define XB_TOP      3328
#define XB_TOPGEN   3392
#define XCD_BAR_WORDS 3456
#define XB_SPIN_CAP (1u << 18)

__device__ __forceinline__ unsigned xb_ld(unsigned* p)              { return __hip_atomic_load(p, __ATOMIC_RELAXED, __HIP_MEMORY_SCOPE_AGENT); }
__device__ __forceinline__ unsigned xb_add(unsigned* p, unsigned v) { return __hip_atomic_fetch_add(p, v, __ATOMIC_RELAXED, __HIP_MEMORY_SCOPE_AGENT); }
__device__ __forceinline__ unsigned xb_xcc_id() { return (unsigned)__builtin_amdgcn_s_getreg((3 << 11) | 20) & 0xFu; }
#define XB_SPIN(cond, bar) do { unsigned _sp = 0; while (cond) { __builtin_amdgcn_s_sleep(1); \
    if ((++_sp & 255u) == 0u) { if (xb_ld(&(bar)[XB_TMO])) break; if (_sp > XB_SPIN_CAP) { atomicAdd(&(bar)[XB_TMO], 1u); break; } } } } while (0)

struct XcdBarrier {
    unsigned* bar; unsigned x;
    volatile LAS unsigned* st;
};

__device__ __forceinline__ XcdBarrier xcd_barrier_post(unsigned* bar, volatile LAS unsigned* st) {
    XcdBarrier b; b.bar = bar; b.x = xb_xcc_id(); b.st = st;
    if (threadIdx.x == 0) (void)xb_add(&bar[XB_XCNT(b.x)], 1u);
    return b;
}
__device__ __forceinline__ void xcd_barrier_complete(unsigned* bar, unsigned x, unsigned& nloc, unsigned& nx) {
    const unsigned G = gridDim.x * gridDim.y * gridDim.z;
    unsigned sum, cnt, mine, sp = 0u;
    for (;;) {
        sum = 0u; cnt = 0u; mine = 0u;
#pragma unroll
        for (unsigned j = 0; j < 16; ++j) { const unsigned c = xb_ld(&bar[XB_XCNT(j)]); sum += c; cnt += (c > 0u) ? 1u : 0u; mine = (j == x) ? c : mine; }
        if (sum == G) break;
        __builtin_amdgcn_s_sleep(1);
        if ((++sp & 255u) == 0u) { if (xb_ld(&bar[XB_TMO])) break; if (sp > XB_SPIN_CAP) { atomicAdd(&bar[XB_TMO], 1u); break; } }
    }
    nloc = mine > 0u ? mine : 1u; nx = cnt > 0u ? cnt : 1u;
}

__device__ __forceinline__ void xcd_barrier(const XcdBarrier& b) {
    asm volatile("s_waitcnt vmcnt(0)" ::: "memory");
    __syncthreads();
    if (threadIdx.x == 0) {
        unsigned* bar = b.bar;
        __builtin_amdgcn_s_waitcnt(0);
        unsigned nloc = b.st[0], nx = b.st[1];
        if (nloc == 0u) { xcd_barrier_complete(bar, b.x, nloc, nx); b.st[0] = nloc; b.st[1] = nx; }
        const unsigned old = xb_add(&bar[XB_XSUB(b.x)], 1u);
        const unsigned gen = old / nloc;
        if (old + 1u == (gen + 1u) * nloc) {
            __builtin_amdgcn_fence(__ATOMIC_RELEASE, "agent");
            asm volatile("s_waitcnt vmcnt(0)" ::: "memory");
            const unsigned og = xb_add(&bar[XB_TOP], 1u);
            const unsigned tg = og / nx;
            if (og + 1u == (tg + 1u) * nx) xb_add(&bar[XB_TOPGEN], 1u);
            else XB_SPIN(xb_ld(&bar[XB_TOPGEN]) == tg, bar);
            __builtin_amdgcn_fence(__ATOMIC_ACQUIRE, "agent");
            xb_add(&bar[XB_XGEN(b.x)], 1u);
            asm volatile("s_waitcnt vmcnt(0)" ::: "memory");
        } else {
            XB_SPIN(xb_ld(&bar[XB_XGEN(b.x)]) == gen, bar);
            __builtin_amdgcn_fence(__ATOMIC_ACQUIRE, "agent");
            asm volatile("s_waitcnt vmcnt(0)" ::: "memory");
        }
    }
    __syncthreads();
}

constexpr int NPH = 1 + 10 * DEPTH;
#ifndef MK_REP_DIFF
#define MK_REP_DIFF 1
#endif
#ifndef MK_REP_DIL
#define MK_REP_DIL 1
#endif
#ifndef MK_REP_BC1
#define MK_REP_BC1 1
#endif
#ifndef MK_REP_BC0
#define MK_REP_BC0 1
#endif
#ifndef MK_EXTRA_SYNC
#define MK_EXTRA_SYNC 0
#endif
__global__ void __launch_bounds__(NT, 2) mega(Params P, int ph_lo, int ph_hi) {
    extern __shared__ __attribute__((aligned(16))) unsigned char lds[];
    cooperative_groups::grid_group grid = cooperative_groups::this_grid();
    unsigned char* ws = P.ws;
    volatile LAS unsigned* bst = (volatile LAS unsigned*)((LAS unsigned char*)lds + (LDS_BYTES - 64));
    if (threadIdx.x < 16) bst[threadIdx.x] = 0u;
    __syncthreads();
    XcdBarrier bar = xcd_barrier_post((unsigned*)(ws + WS_CTL) + 4096, bst);
    bf16* XN = (bf16*)(ws + WS_XN); bf16* PROJ = (bf16*)(ws + WS_PROJ); bf16* MIX = (bf16*)(ws + WS_MIX); bf16* HID = (bf16*)(ws + WS_HID);
    float* Y1 = (float*)(ws + WS_Y1); float* Y2 = (float*)(ws + WS_Y2); float* DT = (float*)(ws + WS_DT);
#define MK_PH(k) (ph_lo <= (k) && (k) < ph_hi)
#define MK_SEAM(k) do { if ((k) + 1 < ph_hi) { if ((k) == 0) grid.sync(); else xcd_barrier(bar); } } while (0)
    if (MK_PH(0)) {
        ph_prep(P, lds);
        ph_row(nullptr, nullptr, P.in[I_X], nullptr, P.in[I_NMPRE], XN, P.in[I_WIN] + 2304, DT);
        MK_SEAM(0);
    }
#pragma unroll 1
    for (int layer = 0; layer < DEPTH; ++layer) {
        const int pb = 1 + 10 * layer;
        const bf16* wl = (const bf16*)(ws + WS_W + (size_t)layer * W_LAYER);
        const float* hin = layer == 0 ? P.in[I_X] : P.out;
        if (MK_PH(pb + 0)) { pg8::Gemm g{XN, wl + WO_IN / 2, MROWS, NPROJ, DM, 0}; pg8::EpiBf16R<0> e{PROJ, NPROJ, 0}; ph_gemm(g, e, lds); MK_SEAM(pb + 0); }
        if (MK_PH(pb + 1)) {
            ph_conv(P, layer);
#pragma unroll 1
            for (int rep = 0; rep < MK_REP_DIL; ++rep) { ph_dilated(P, lds); __syncthreads(); }
            MK_SEAM(pb + 1); }
        if (MK_PH(pb + 2)) {
#pragma unroll 1
            for (int rep = 0; rep < MK_REP_BC0; ++rep) { ph_lru<0>(P, layer); __syncthreads(); ph_ssd<0>(P, layer, lds); __syncthreads(); }
            MK_SEAM(pb + 2); }
        if (MK_PH(pb + 3)) { ph_scan(P); MK_SEAM(pb + 3);
#pragma unroll 1
            for (int rep = 0; rep < MK_EXTRA_SYNC; ++rep) xcd_barrier(bar); }
        if (MK_PH(pb + 4)) {
#pragma unroll 1
            for (int rep = 0; rep < MK_REP_DIFF; ++rep) { ph_diff(P, layer, lds); __syncthreads(); }
#pragma unroll 1
            for (int rep = 0; rep < MK_REP_BC1; ++rep) { ph_lru<1>(P, layer); __syncthreads(); ph_ssd<1>(P, layer, lds); __syncthreads(); }
            MK_SEAM(pb + 4); }
        if (MK_PH(pb + 5)) { pg8::Gemm g{MIX, wl + WO_OUT / 2, MROWS, DM, DM, 0}; pg8::EpiF32 e{Y1, DM, 0}; ph_gemm(g, e, lds); MK_SEAM(pb + 5); }
        if (MK_PH(pb + 6)) { ph_row(Y1, P.in[I_NMPOST] + layer * DM, hin, P.out, P.in[I_NFPRE] + layer * DM, XN, nullptr, nullptr); MK_SEAM(pb + 6); }
        if (MK_PH(pb + 7)) { pg8::Gemm g{XN, wl + WO_UP / 2, MROWS, DFF, DM, 0}; pg8::EpiBf16R<2> e{HID, DFF, 0}; ph_gemm(g, e, lds); MK_SEAM(pb + 7); }
        if (MK_PH(pb + 8)) { pg8::Gemm g{HID, wl + WO_DOWN / 2, MROWS, DM, DFF, 0}; pg8::EpiF32 e{Y2, DM, 0}; ph_gemm(g, e, lds); MK_SEAM(pb + 8); }
        if (MK_PH(pb + 9)) { const bool last = layer == DEPTH - 1;
            ph_row(Y2, P.in[I_NFPOST] + layer * DM, P.out, P.out, last ? nullptr : P.in[I_NMPRE] + (layer + 1) * DM, XN, last ? nullptr : P.in[I_WIN] + (size_t)(layer + 1) * DM * PIN + 2304, DT);
            MK_SEAM(pb + 9); }
    }
}
}

#ifndef MK_N_LAUNCHES
#define MK_N_LAUNCHES 1
#endif
extern "C" void kernel_launch(void* const* d_in, const int* in_sizes, int n_in, void* d_out, int out_size, void* d_ws, size_t ws_size, hipStream_t stream) {
    using namespace mk;
    static int grid = 0;
    if (grid == 0) {
        if (n_in != N_IN || in_sizes[0] != MROWS * DM || out_size != MROWS * DM || ws_size < WS_END) {
            fprintf(stderr, "kernel_launch: unexpected shapes: n_in %d in0 %d out %d ws %zu (need %zu)\n", n_in, n_in > 0 ? in_sizes[0] : -1, out_size, ws_size, (size_t)WS_END); grid = -1; return; }
        (void)hipFuncSetAttribute((const void*)mega, hipFuncAttributeMaxDynamicSharedMemorySize, LDS_BYTES);
        int dev = 0, cus = 0, per_cu = 0;
        (void)hipGetDevice(&dev);
        (void)hipDeviceGetAttribute(&cus, hipDeviceAttributeMultiprocessorCount, dev);
        (void)hipOccupancyMaxActiveBlocksPerMultiprocessor(&per_cu, (const void*)mega, NT, LDS_BYTES);
        (void)hipGetLastError();
        if (per_cu < 1 || cus < 1) { fprintf(stderr, "kernel_launch: occupancy query: %d blocks/CU, %d CUs\n", per_cu, cus); grid = -1; return; }
        grid = cus;
    }
    if (grid < 0) return;
    Params P{};
    for (int i = 0; i < N_IN; ++i) P.in[i] = (const float*)d_in[i];
    P.out = (float*)d_out; P.ws = (unsigned char*)d_ws;
#if MK_N_LAUNCHES == 1
    (void)hipMemsetAsync((unsigned char*)d_ws + WS_CTL, 0, 65536, stream);
    int lo = 0, hi = NPH;
    void* args[] = {(void*)&P, (void*)&lo, (void*)&hi};
    hipError_t e = hipLaunchCooperativeKernel((const void*)mega, dim3(grid), dim3(NT), args, LDS_BYTES, stream);
    if (e != hipSuccess) fprintf(stderr, "kernel_launch: cooperative launch failed: %s (grid %d)\n", hipGetErrorString(e), grid);
#else
    for (int p = 0; p < NPH; ++p) hipLaunchKernelGGL(mega, dim3(grid), dim3(NT), LDS_BYTES, stream, P, p, p + 1);
#endif
}
```
